# Optimizing an MI355X kernel written in HIP

```python
import jax, jax.numpy as jnp
from jax import lax
import numpy as np

D_MODEL = 2048
BATCH = 16
SEQ = 2048
DEPTH = 4
DEC_BATCH = 1
DEC_SEQ = 8192
PAST_LEN = 128

HG_HEADS = 8
HG_KDIM = 128
HG_VDIM = 128
HG_KW = HG_HEADS * HG_KDIM
HG_WIDTH = HG_HEADS * HG_VDIM
HG_CHUNK = 64
HEAD_DIM = 128
ATT_HEADS = 8
ATT_KV_HEADS = 2
ATT_WIDTH = ATT_HEADS * HEAD_DIM
KV_WIDTH = ATT_KV_HEADS * HEAD_DIM
WINDOW = 128
ROPE_THETA = 10000.0
D_FF = ((-(-8 * D_MODEL // 3) + 255) // 256) * 256
DEEPNORM_ALPHA = (2 * DEPTH) ** 0.25
DEEPNORM_BETA = (8 * DEPTH) ** -0.25
LN_EPS = 1e-5
RMS_EPS = 1e-6
IN_SPLITS = (HG_KW, HG_KW, HG_KW, HG_WIDTH, HG_WIDTH, ATT_WIDTH, KV_WIDTH, KV_WIDTH, D_MODEL, D_MODEL)
IN_WIDTH = sum(IN_SPLITS)

kernel_name = 'hybrid_hgrn2_swa_deepnorm_encoder'


def _split_points():
    pts, acc = [], 0
    for w in IN_SPLITS[:-1]:
        acc += w
        pts.append(acc)
    return pts


def layer_norm(x, g, b):
    xf = x.astype(jnp.float32)
    mu = jnp.mean(xf, axis=-1, keepdims=True)
    var = jnp.mean(jnp.square(xf - mu), axis=-1, keepdims=True)
    y = (xf - mu) * lax.rsqrt(var + LN_EPS) * g.astype(jnp.float32) + b.astype(jnp.float32)
    return y.astype(x.dtype)


def rope_tables(L):
    inv = 1.0 / (ROPE_THETA ** (jnp.arange(0, HEAD_DIM, 2, dtype=jnp.float32) / HEAD_DIM))
    ang = jnp.arange(L, dtype=jnp.float32)[:, None] * inv[None, :]
    return jnp.cos(ang), jnp.sin(ang)


def apply_rope(x, cos, sin):
    x1, x2 = jnp.split(x.astype(jnp.float32), 2, axis=-1)
    c = cos[None, :, None, :]
    s = sin[None, :, None, :]
    return jnp.concatenate([x1 * c - x2 * s, x2 * c + x1 * s], axis=-1).astype(x.dtype)


def hgrn2_scan(q, k, v, log_f):
    B, L, H, dk = q.shape
    dv = v.shape[-1]
    C = HG_CHUNK
    N = L // C

    def chunks(t):
        return t.reshape(B, N, C, H, t.shape[-1]).transpose(1, 0, 3, 2, 4)

    causal = jnp.tril(jnp.ones((C, C), dtype=bool))[None, None, :, :, None]

    def step(S, inp):
        qc, kc, vc, gc = inp
        b = jnp.cumsum(gc, axis=2)
        b_end = b[:, :, -1:, :]
        o_inter = jnp.einsum('bhck,bhkv->bhcv', qc * jnp.exp(b), S)
        rel = jnp.where(causal, b[:, :, :, None, :] - b[:, :, None, :, :], -jnp.inf)
        scores = jnp.einsum('bhtk,bhsk,bhtsk->bhts', qc, kc, jnp.exp(rel))
        o_intra = jnp.einsum('bhts,bhsv->bhtv', scores, vc)
        S_new = jnp.exp(b_end[:, :, 0, :])[..., None] * S + jnp.einsum(
            'bhck,bhcv->bhkv', kc * jnp.exp(b_end - b), vc)
        return S_new, o_inter + o_intra

    S0 = jnp.zeros((B, H, dk, dv), jnp.float32)
    _, o = lax.scan(step, S0, (chunks(q), chunks(k), chunks(v), chunks(log_f)))
    return o.transpose(1, 0, 3, 2, 4).reshape(B, L, H, dv)


def hgrn2_branch(hq, hf_fwd, hf_bwd, hi, hg, lower_bound, norm_g):
    B, L, _ = hq.shape
    f32 = jnp.float32
    q = jax.nn.silu(hq.astype(f32)).reshape(B, L, HG_HEADS, HG_KDIM)
    v = hi.astype(f32).reshape(B, L, HG_HEADS, HG_VDIM)
    lb_fwd, lb_bwd = jnp.split(lower_bound, 2)

    def gates(z, lb):
        f = lb.reshape(HG_HEADS, HG_KDIM) + (1.0 - lb.reshape(HG_HEADS, HG_KDIM)) * jax.nn.sigmoid(
            z.astype(f32).reshape(B, L, HG_HEADS, HG_KDIM))
        return 1.0 - f, jnp.log(f)

    k_f, g_f = gates(hf_fwd, lb_fwd)
    k_b, g_b = gates(hf_bwd, lb_bwd)
    o_fwd = hgrn2_scan(q, k_f, v, g_f)
    flip = lambda t: jnp.flip(t, axis=1)
    o_bwd = flip(hgrn2_scan(flip(q), flip(k_b), flip(v), flip(g_b)))
    o = o_fwd + o_bwd
    o = o * lax.rsqrt(jnp.mean(jnp.square(o), axis=-1, keepdims=True) + RMS_EPS) * norm_g.astype(f32)
    o = o.reshape(B, L, HG_WIDTH) * jax.nn.silu(hg.astype(f32))
    return o.astype(hq.dtype)


def window_attention_branch(aq, ak, av, sink, cos, sin):
    B, L, _ = aq.shape
    W = WINDOW
    N = L // W
    G = ATT_HEADS // ATT_KV_HEADS
    q = apply_rope(aq.reshape(B, L, ATT_HEADS, HEAD_DIM), cos, sin)
    k = apply_rope(ak.reshape(B, L, ATT_KV_HEADS, HEAD_DIM), cos, sin)
    v = av.reshape(B, L, ATT_KV_HEADS, HEAD_DIM)
    qb = q.reshape(B, N, W, ATT_KV_HEADS, G, HEAD_DIM)

    def neighbours(t):
        tp = jnp.pad(t, ((0, 0), (W, W), (0, 0), (0, 0))).reshape(B, N + 2, W, ATT_KV_HEADS, HEAD_DIM)
        return jnp.concatenate([tp[:, :-2], tp[:, 1:-1], tp[:, 2:]], axis=2)

    kb = neighbours(k)
    vb = neighbours(v)
    s = jnp.einsum('bnqhgd,bnkhd->bnhgqk', qb, kb).astype(jnp.float32) * (HEAD_DIM ** -0.5)
    i = jnp.arange(W)[:, None]
    j = jnp.arange(3 * W)[None, :]
    n = jnp.arange(N)[:, None, None]
    kpos = (n - 1) * W + j[None]
    valid = (jnp.abs(j - W - i)[None] <= WINDOW) & (kpos >= 0) & (kpos < L)
    s = jnp.where(valid[None, :, None, None], s, -jnp.inf)
    sink_logit = jnp.broadcast_to(
        sink.astype(jnp.float32).reshape(1, 1, ATT_KV_HEADS, G, 1, 1), s.shape[:-1] + (1,))
    p = jax.nn.softmax(jnp.concatenate([s, sink_logit], axis=-1), axis=-1)[..., :-1]
    o = jnp.einsum('bnhgqk,bnkhd->bnqhgd', p.astype(vb.dtype), vb)
    return o.reshape(B, L, ATT_WIDTH)


def mixer(h, w_in, lower_bound, hg_norm_g, sink, w_branch_a, w_branch_b, w_out, cos, sin):
    proj = h @ w_in
    hq, hf_f, hf_b, hi, hg, aq, ak, av, gate_a, gate_b = jnp.split(proj, _split_points(), axis=-1)
    a = hgrn2_branch(hq, hf_f, hf_b, hi, hg, lower_bound, hg_norm_g)
    b = window_attention_branch(aq, ak, av, sink, cos, sin)
    merged = jax.nn.sigmoid(gate_a) * (a @ w_branch_a) + jax.nn.sigmoid(gate_b) * (b @ w_branch_b)
    return merged @ w_out


def swiglu(h, w_ffn_in, w_ffn_out):
    gate, up = jnp.split(h @ w_ffn_in, 2, axis=-1)
    return (jax.nn.silu(gate) * up) @ w_ffn_out


def encoder_trunk(x, ln_in_g, ln_in_b, w_in, lb_logits, hg_norm_g, attn_sink, w_branch_a, w_branch_b,
                  w_out, ln1_g, ln1_b, w_ffn_in, w_ffn_out, ln2_g, ln2_b):
    L = x.shape[1]
    cos, sin = rope_tables(L)
    p = jax.nn.softmax(lb_logits.astype(jnp.float32), axis=0)
    lower_bounds = jnp.cumsum(p, axis=0) - p[0:1]
    h = layer_norm(x, ln_in_g, ln_in_b)
    for l in range(DEPTH):
        mix = mixer(h, w_in[l], lower_bounds[l], hg_norm_g[l], attn_sink[l],
                    w_branch_a[l], w_branch_b[l], w_out[l], cos, sin)
        h = layer_norm(DEEPNORM_ALPHA * h + mix, ln1_g[l], ln1_b[l])
        h = layer_norm(DEEPNORM_ALPHA * h + swiglu(h, w_ffn_in[l], w_ffn_out[l]), ln2_g[l], ln2_b[l])
    return h


def setup_inputs(seed: int = 0) -> dict:
    key = jax.random.key(seed)
    ks = jax.random.split(key, 18)
    nrm = lambda k, shape, scale: jax.random.normal(k, shape, jnp.float32) * scale
    return {
        'x_prompt': nrm(ks[0], (BATCH, SEQ, D_MODEL), 1.0),
        'x_sample': nrm(ks[1], (DEC_BATCH, DEC_SEQ, D_MODEL), 1.0),
        'ln_in_g': 1.0 + nrm(ks[2], (D_MODEL,), 0.02),
        'ln_in_b': nrm(ks[3], (D_MODEL,), 0.02),
        'w_in': nrm(ks[4], (DEPTH, D_MODEL, IN_WIDTH), D_MODEL ** -0.5),
        'lb_logits': nrm(ks[5], (DEPTH, 2 * HG_KW), 0.1),
        'hg_norm_g': 1.0 + nrm(ks[6], (DEPTH, HG_VDIM), 0.02),
        'attn_sink': nrm(ks[7], (DEPTH, ATT_HEADS), 0.5),
        'w_branch_a': nrm(ks[8], (DEPTH, HG_WIDTH, D_MODEL), HG_WIDTH ** -0.5),
        'w_branch_b': nrm(ks[9], (DEPTH, ATT_WIDTH, D_MODEL), ATT_WIDTH ** -0.5),
        'w_out': nrm(ks[10], (DEPTH, D_MODEL, D_MODEL), DEEPNORM_BETA * D_MODEL ** -0.5),
        'ln1_g': 1.0 + nrm(ks[11], (DEPTH, D_MODEL), 0.02),
        'ln1_b': nrm(ks[12], (DEPTH, D_MODEL), 0.02),
        'w_ffn_in': nrm(ks[13], (DEPTH, D_MODEL, 2 * D_FF), D_MODEL ** -0.5),
        'w_ffn_out': nrm(ks[14], (DEPTH, D_FF, D_MODEL), DEEPNORM_BETA * D_FF ** -0.5),
        'ln2_g': 1.0 + nrm(ks[15], (DEPTH, D_MODEL), 0.02),
        'ln2_b': nrm(ks[16], (DEPTH, D_MODEL), 0.02),
    }


def reference(x_prompt, x_sample, ln_in_g, ln_in_b, w_in, lb_logits, hg_norm_g, attn_sink, w_branch_a,
              w_branch_b, w_out, ln1_g, ln1_b, w_ffn_in, w_ffn_out, ln2_g, ln2_b):
    y_prompt = encoder_trunk(x_prompt, ln_in_g, ln_in_b, w_in, lb_logits, hg_norm_g, attn_sink, w_branch_a,
                             w_branch_b, w_out, ln1_g, ln1_b, w_ffn_in, w_ffn_out, ln2_g, ln2_b)
    y_sample = encoder_trunk(x_sample, ln_in_g, ln_in_b, w_in, lb_logits, hg_norm_g, attn_sink, w_branch_a,
                             w_branch_b, w_out, ln1_g, ln1_b, w_ffn_in, w_ffn_out, ln2_g, ln2_b)
    return (y_prompt, y_sample)
```

```cpp
#include <hip/hip_runtime.h>
#include <cstdio>
#include <cstdint>

#ifndef MK_PER_PHASE_LAUNCH
#define MK_PER_PHASE_LAUNCH 0
#endif

namespace pg8 {
#define PG8_LAS __attribute__((address_space(3)))
typedef unsigned short bf16_t;
typedef short bf16x8 __attribute__((ext_vector_type(8)));
typedef _Float16 f16x8 __attribute__((ext_vector_type(8)));
typedef float f32x4 __attribute__((ext_vector_type(4)));
typedef unsigned u32x4 __attribute__((ext_vector_type(4)));
typedef unsigned u32x2 __attribute__((ext_vector_type(2)));
constexpr int BM = 256, BK = 64, HALF = 128, HTB = HALF * BK * 2, STAGE_BYTES = 8 * HTB, NXCD = 8, WGM = 4;

__host__ __device__ __forceinline__ int lds_byte(int r, int c) { const int st = (r >> 4) * 2 + (c >> 5), rr = r & 15, cc = c & 31, ob = rr * 64 + cc * 2; return st * 1024 + (ob ^ (((ob >> 9) & 1) << 5)); }
__host__ __device__ __forceinline__ void stage_rc(int b, int& R, int& C) { const int st = b / 1024, sb = b % 1024, swz = sb ^ (((sb >> 9) & 1) << 5); R = (st >> 1) * 16 + swz / 64; C = (st & 1) * 32 + (swz % 64) / 2; }
__host__ __device__ __forceinline__ int perm32(int rho) { const int n = rho >> 4, i = rho & 15; return 8 * (i >> 2) + 4 * n + (i & 3); }

struct Unit { int pm, pn; };
struct Gemm { const bf16_t* A; const bf16_t* A2; const bf16_t* Bt; int M, N, K, lda; };

struct StaticOrder {
    int nM, nN, nwg, G, c;
    __host__ __device__ void init(int M, int N, int G_, int c_) { nM = M / BM; nN = N / BM; nwg = nM * nN; G = G_; c = c_; }
    __host__ __device__ bool next(int i, Unit& u) const {
        const long L = (long)i * G + c; if (L >= nwg) return false;
        int wgid = (int)L; { const int q = nwg / NXCD, r = nwg % NXCD, xcd = wgid % NXCD, off = wgid / NXCD; wgid = (xcd < r ? xcd * (q + 1) : r * (q + 1) + (xcd - r) * q) + off; }
        const int nig = WGM * nN, gid = wgid / nig, fm = gid * WGM, gsz = (nM - fm) < WGM ? (nM - fm) : WGM;
        u.pm = fm + ((wgid % nig) % gsz); u.pn = (wgid % nig) / gsz; return true;
    }
    __device__ __forceinline__ void a_ready(const Unit&) const {}
    __device__ __forceinline__ void done(const Unit&) const {}
};

__device__ __forceinline__ unsigned cvt_pk_bf16(float lo, float hi) { unsigned r; asm volatile("v_cvt_pk_bf16_f32 %0, %1, %2" : "=v"(r) : "v"(lo), "v"(hi)); return r; }
__device__ __forceinline__ unsigned cvt_pk_f16(float lo, float hi) { unsigned r; asm volatile("v_cvt_pk_f16_f32 %0, %1, %2" : "=v"(r) : "v"(lo), "v"(hi)); return r; }

#ifndef GP_ALIGN
#define GP_ALIGN true
#endif
#ifndef GP_SP2
#define GP_SP2 true
#endif
template <class Epi, class Sched, bool ALIGN_EPI = GP_ALIGN, bool SP2 = GP_SP2>
__device__ __forceinline__ void gemm_phase(PG8_LAS unsigned char* lds, const Gemm g_, const Sched& S, const Epi& E, int wid_) {
    int tid_; asm volatile("v_mbcnt_lo_u32_b32 %0, -1, 0\n\tv_mbcnt_hi_u32_b32 %0, -1, %0" : "=v"(tid_)); tid_ += wid_ * 64;
    Gemm g = g_; asm volatile("" : "+s"(g.A), "+s"(g.A2), "+s"(g.Bt));
    const int tid = tid_, wid = __builtin_amdgcn_readfirstlane(tid >> 6), lane = tid & 63, wr = wid >> 2, wc = wid & 3, fr = lane & 15, fq = lane >> 4;
    const int K = g.K, nt = K / BK;
    unsigned voffA[2], voffB[2];
#define PG8_VOFF(tidv) do { _Pragma("unroll") for (int i = 0; i < 2; ++i) { int R, C; stage_rc((tidv) * 16 + i * 8192, R, C); const int Rb = Epi::PERM ? ((R & ~31) + perm32(R & 31)) : R; \
        voffA[i] = (unsigned)(R * g.lda + C) * 2u; voffB[i] = (unsigned)(Rb * K + C) * 2u; } } while (0)
    PG8_VOFF(tid);
    constexpr unsigned kstep = BK * 2;
    const unsigned hstep = (unsigned)(HALF * K * 2), hstepA = (unsigned)(HALF * g.lda * 2);
    const unsigned tstep = 2 * hstep, tstepA = 2 * hstepA;
    const bool dualA = g.A2 != nullptr; const int ntA = dualA ? nt / 2 : nt; const int a2delta = dualA ? (int)(((const char*)g.A2 - (const char*)g.A) - (ptrdiff_t)ntA * (ptrdiff_t)kstep) : 0;
    const unsigned ldsw = (unsigned)wid * 1024u;
    const int aoff = lds_byte(wr * 64 + fr, fq * 8), boff = lds_byte(wc * 32 + fr, fq * 8);
#define PG8_SA(b, h) (((b) * 2 + (h)) * HTB)
#define PG8_SB(b, h) ((4 + (b) * 2 + (h)) * HTB)
#define PG8_STAGE(bufoff, gbase, voff) do { _Pragma("unroll") for (int _i = 0; _i < 2; ++_i) \
        __builtin_amdgcn_global_load_lds((const unsigned*)((const char*)(gbase) + (voff)[_i]), (PG8_LAS unsigned*)(lds + (bufoff) + ldsw + _i * 8192), 16, 0, 0); } while (0)
#define PG8_LDA(dst, b, h) do { _Pragma("unroll") for (int m = 0; m < 4; ++m) _Pragma("unroll") for (int k = 0; k < 2; ++k) dst[m][k] = *(const PG8_LAS bf16x8*)(lds + PG8_SA(b, h) + aoff + m * 2048 + k * 1024); } while (0)
#define PG8_LDB(dst, b, h) do { _Pragma("unroll") for (int n = 0; n < 2; ++n) _Pragma("unroll") for (int k = 0; k < 2; ++k) dst[n][k] = *(const PG8_LAS bf16x8*)(lds + PG8_SB(b, h) + boff + n * 2048 + k * 1024); } while (0)
#define PG8_MMA(ai, bj, At, Bt) do { __builtin_amdgcn_s_setprio(1); _Pragma("unroll") for (int m = 0; m < 4; ++m) _Pragma("unroll") for (int n = 0; n < 2; ++n) _Pragma("unroll") for (int k = 0; k < 2; ++k) { \
        if constexpr (Epi::F16) acc[ai][bj][m][n] = __builtin_amdgcn_mfma_f32_16x16x32_f16(__builtin_bit_cast(f16x8, Bt[n][k]), __builtin_bit_cast(f16x8, At[m][k]), acc[ai][bj][m][n], 0, 0, 0); \
        else acc[ai][bj][m][n] = __builtin_amdgcn_mfma_f32_16x16x32_bf16(Bt[n][k], At[m][k], acc[ai][bj][m][n], 0, 0, 0); } __builtin_amdgcn_s_setprio(0); } while (0)
#define PG8_WAIT_V(n) asm volatile("s_waitcnt vmcnt(" #n ")" ::: "memory")
#define PG8_WAIT_L(n) asm volatile("s_waitcnt lgkmcnt(" #n ")" ::: "memory")
#define PG8_BAR __builtin_amdgcn_s_barrier()
#define PG8_SCHED __builtin_amdgcn_sched_barrier(0)
    Unit cur, nxt; int ui = 0;
    if (!S.next(0, cur)) return;
    f32x4 acc[2][2][4][2];
#pragma unroll
    for (int a = 0; a < 2; ++a)
#pragma unroll
        for (int b = 0; b < 2; ++b)
#pragma unroll
            for (int m = 0; m < 4; ++m)
#pragma unroll
                for (int n = 0; n < 2; ++n) acc[a][b][m][n] = (f32x4){0.f, 0.f, 0.f, 0.f};
    bf16x8 At[4][2], B0[2][2], B1[2][2];
    const char* cA = (const char*)g.A + (size_t)cur.pm * tstepA; const char* cB = (const char*)g.Bt + (size_t)cur.pn * tstep;
    S.a_ready(cur);
    if constexpr (SP2) {
        PG8_STAGE(PG8_SB(0, 0), cB, voffB); PG8_STAGE(PG8_SB(0, 1), cB + hstep, voffB); PG8_STAGE(PG8_SA(0, 0), cA, voffA); PG8_STAGE(PG8_SA(0, 1), cA + hstepA, voffA);
        if (wr == 1) PG8_BAR;
        PG8_WAIT_V(2); PG8_BAR;
        PG8_STAGE(PG8_SB(1, 0), cB + kstep, voffB); PG8_STAGE(PG8_SA(1, 0), cA + kstep, voffA); PG8_STAGE(PG8_SB(1, 1), cB + hstep + kstep, voffB);
        PG8_WAIT_V(6); PG8_BAR;
    } else {
        PG8_STAGE(PG8_SB(0, 0), cB, voffB); PG8_STAGE(PG8_SA(0, 0), cA, voffA); PG8_STAGE(PG8_SB(0, 1), cB + hstep, voffB); PG8_STAGE(PG8_SA(0, 1), cA + hstepA, voffA);
        if (wr == 1) PG8_BAR;
        PG8_WAIT_V(4); PG8_BAR;
        PG8_STAGE(PG8_SB(1, 0), cB + kstep, voffB); PG8_STAGE(PG8_SA(1, 0), cA + kstep, voffA); PG8_STAGE(PG8_SB(1, 1), cB + hstep + kstep, voffB);
        PG8_WAIT_V(6); PG8_BAR;
    }
    for (;;) {
        const bool has_next = S.next(ui + 1, nxt);
        const char* nA = has_next ? (const char*)g.A + (size_t)nxt.pm * tstepA : cA; const char* nB = has_next ? (const char*)g.Bt + (size_t)nxt.pn * tstep : cB;
        for (int t = 0; t < nt; t += 2) {
            const bool last = (t == nt - 2);
            const char* a1 = cA + (ptrdiff_t)((t >= ntA ? a2delta : 0) + (int)((t + 1) * kstep));
            const char* a2 = last ? nA : cA + (ptrdiff_t)((t + 2 >= ntA ? a2delta : 0) + (int)((t + 2) * kstep)); const char* b2 = last ? nB : cB + (size_t)((t + 2) * kstep);
            const char* a3 = a2 + kstep; const char* b3 = b2 + kstep;
            if (last && has_next) S.a_ready(nxt);
            if constexpr (Epi::HAS_MID) { if (t == ntA) { int fr_ = fr, fq_ = fq; asm volatile("" : "+v"(fr_), "+v"(fq_)); E.mid(acc, cur, wr, wc, fr_, fq_); } }
            if constexpr (SP2) {
            PG8_LDB(B0, 0, 0); PG8_LDB(B1, 0, 1); PG8_SCHED; PG8_LDA(At, 0, 0); PG8_STAGE(PG8_SA(1, 1), a1 + hstepA, voffA);
            PG8_WAIT_V(8); PG8_WAIT_L(0); PG8_BAR; PG8_MMA(0, 0, At, B0); PG8_MMA(0, 1, At, B1); PG8_BAR; PG8_SCHED;
            PG8_LDA(At, 0, 1); PG8_STAGE(PG8_SB(0, 0), b2, voffB); PG8_STAGE(PG8_SB(0, 1), b2 + hstep, voffB); PG8_STAGE(PG8_SA(0, 0), a2, voffA);
            PG8_WAIT_V(8); PG8_WAIT_L(0); PG8_BAR; PG8_MMA(1, 0, At, B0); PG8_MMA(1, 1, At, B1); PG8_BAR; PG8_SCHED;
            PG8_LDB(B0, 1, 0); PG8_LDB(B1, 1, 1); PG8_SCHED; PG8_LDA(At, 1, 0); PG8_STAGE(PG8_SA(0, 1), a2 + hstepA, voffA);
            PG8_WAIT_V(8); PG8_WAIT_L(0); PG8_BAR; PG8_MMA(0, 0, At, B0); PG8_MMA(0, 1, At, B1); PG8_BAR; PG8_SCHED;
            PG8_LDA(At, 1, 1); PG8_STAGE(PG8_SB(1, 0), b3, voffB); PG8_STAGE(PG8_SB(1, 1), b3 + hstep, voffB); PG8_STAGE(PG8_SA(1, 0), a3, voffA);
            PG8_WAIT_V(8); PG8_WAIT_L(0); PG8_BAR; PG8_MMA(1, 0, At, B0); PG8_MMA(1, 1, At, B1); PG8_BAR; PG8_SCHED;
            } else {
            PG8_LDB(B0, 0, 0); PG8_SCHED; PG8_LDA(At, 0, 0); PG8_STAGE(PG8_SA(1, 1), a1 + hstepA, voffA);
            PG8_WAIT_L(8); PG8_BAR; PG8_WAIT_L(0); PG8_MMA(0, 0, At, B0); PG8_BAR; PG8_SCHED;
            PG8_LDB(B1, 0, 1); PG8_STAGE(PG8_SB(0, 0), b2, voffB);
            PG8_BAR; PG8_WAIT_L(0); PG8_MMA(0, 1, At, B1); PG8_BAR;
            PG8_LDA(At, 0, 1); PG8_STAGE(PG8_SA(0, 0), a2, voffA);
            PG8_BAR; PG8_WAIT_L(0); PG8_MMA(1, 0, At, B0); PG8_BAR; PG8_SCHED;
            PG8_STAGE(PG8_SB(0, 1), b2 + hstep, voffB);
            PG8_WAIT_V(6); PG8_BAR; PG8_MMA(1, 1, At, B1); PG8_BAR;
            PG8_LDB(B0, 1, 0); PG8_SCHED; PG8_LDA(At, 1, 0); PG8_STAGE(PG8_SA(0, 1), a2 + hstepA, voffA);
            PG8_WAIT_L(8); PG8_BAR; PG8_WAIT_L(0); PG8_MMA(0, 0, At, B0); PG8_BAR; PG8_SCHED;
            PG8_LDB(B1, 1, 1); PG8_STAGE(PG8_SB(1, 0), b3, voffB);
            PG8_BAR; PG8_WAIT_L(0); PG8_MMA(0, 1, At, B1); PG8_BAR;
            PG8_LDA(At, 1, 1); PG8_STAGE(PG8_SA(1, 0), a3, voffA);
            PG8_BAR; PG8_WAIT_L(0); PG8_MMA(1, 0, At, B0); PG8_BAR; PG8_SCHED;
            PG8_STAGE(PG8_SB(1, 1), b3 + hstep, voffB);
            PG8_WAIT_V(6); PG8_BAR; PG8_MMA(1, 1, At, B1); PG8_BAR;
            }
        }
        if constexpr (ALIGN_EPI) { if (wr == 0) PG8_BAR; }
        { int fr_ = fr, fq_ = fq; asm volatile("" : "+v"(fr_), "+v"(fq_));
          E(acc, cur, wr, wc, fr_, fq_); }
        if (!has_next) break;
        { int tid2; asm volatile("v_mbcnt_lo_u32_b32 %0, -1, 0\n\tv_mbcnt_hi_u32_b32 %0, -1, %0" : "=v"(tid2)); tid2 += wid_ * 64; PG8_VOFF(tid2); }
#pragma unroll
        for (int a = 0; a < 2; ++a)
#pragma unroll
            for (int b = 0; b < 2; ++b)
#pragma unroll
                for (int m = 0; m < 4; ++m)
#pragma unroll
                    for (int n = 0; n < 2; ++n) acc[a][b][m][n] = (f32x4){0.f, 0.f, 0.f, 0.f};
        cur = nxt; cA = nA; cB = nB; ++ui;
        if constexpr (ALIGN_EPI) { if (wr == 1) PG8_BAR; }
    }
    PG8_WAIT_V(0);
    if constexpr (!ALIGN_EPI) { if (wr == 0) PG8_BAR; }
    PG8_BAR;
#undef PG8_VOFF
#undef PG8_SA
#undef PG8_SB
#undef PG8_STAGE
#undef PG8_LDA
#undef PG8_LDB
#undef PG8_MMA
#undef PG8_WAIT_V
#undef PG8_WAIT_L
#undef PG8_BAR
#undef PG8_SCHED
}
}

constexpr int NWAVES = 8, NTHREADS = NWAVES * 64;
constexpr int DM = 2048, DEPTH = 4, NPROJ = 10752, DFF = 5632, NFFN = 2 * DFF;
constexpr int SEQ_P = 2048, NSEQ_P = 16, SEQ_S = 8192;
constexpr int MTOK = NSEQ_P * SEQ_P + SEQ_S;
constexpr int HW = 1024;
constexpr int KVW = 256;
constexpr float LN_EPS = 1e-5f, RMS_EPS = 1e-6f;
constexpr float ALPHA = 1.6817928305074292f;
constexpr float LOG2E = 1.4426950408889634f;
constexpr float QSCALE = 0.08838834764831845f * 1.4426950408889634f;

constexpr size_t MiB = 1u << 20;
constexpr size_t WS_CTL = 0;
constexpr size_t WS_STATS = 64 * 1024;
constexpr size_t STATS_BYTES = (size_t)MTOK * 8;
constexpr size_t WS_CVEC = WS_STATS + 9 * STATS_BYTES;
constexpr size_t CVEC_LAYER = (size_t)(2 * NPROJ + 2 * NFFN) * 4;
constexpr size_t ZERO_BYTES = 4 * MiB;
static_assert(WS_CVEC + DEPTH * CVEC_LAYER <= ZERO_BYTES, "zeroed region");
constexpr size_t WS_LB = 4 * MiB;
constexpr size_t WS_COS = 5 * MiB, WS_SIN = 7 * MiB;
constexpr size_t WS_SEGE = 9 * MiB;
constexpr size_t WS_SEGD = 13 * MiB;
constexpr size_t WS_W = 14 * MiB;
constexpr size_t W_IN = 0, W_A = W_IN + (size_t)NPROJ * DM * 2, W_B = W_A + (size_t)DM * HW * 2, W_OUT = W_B + (size_t)DM * HW * 2,
                 W_FIN = W_OUT + (size_t)DM * DM * 2, W_FOUT = W_FIN + (size_t)NFFN * DM * 2, W_END = W_FOUT + (size_t)DM * DFF * 2;
static_assert(W_END == 124 * MiB, "weights per layer");
constexpr size_t WS_YBF = WS_W + 124 * MiB;
static_assert(WS_SEGE + 64 * 512 * 32 * 4 <= WS_SEGD && WS_SEGD + 64 * 128 * 4 <= WS_W, "segment state buffers");
constexpr size_t WS_PROJ = WS_YBF + 160 * MiB;
constexpr size_t SZ1K = (size_t)MTOK * HW * 2;
constexpr size_t P_HQ = WS_PROJ, P_GF = P_HQ + SZ1K, P_GB = P_GF + SZ1K, P_HI = P_GB + SZ1K, P_HG = P_HI + SZ1K, P_AQ = P_HG + SZ1K,
                 P_AK = P_AQ + SZ1K, P_AV = P_AK + SZ1K / 4, P_GA = P_AV + SZ1K / 4, P_GBB = P_GA + 2 * SZ1K, P_END = P_GBB + 2 * SZ1K;
constexpr size_t WS_MERGED = P_HQ;
constexpr size_t WS_HID = P_HQ;
static_assert((size_t)MTOK * DFF * 2 <= P_END - P_HQ, "hidden overlay");
constexpr size_t WS_AOUT = P_END, WS_BOUT = WS_AOUT + SZ1K, WS_OBWD = WS_BOUT + SZ1K, WS_END = WS_OBWD + SZ1K;
static_assert(WS_END <= 1408 * MiB, "workspace");

constexpr int RING_BYTES = 131072;
constexpr int MISC_OFF = RING_BYTES;
constexpr int LDS_BYTES = 147456;

#define GAS __attribute__((address_space(1)))
#define LAS __attribute__((address_space(3)))
typedef unsigned short bf16;
typedef float f32x4 __attribute__((ext_vector_type(4)));
typedef float f32x16 __attribute__((ext_vector_type(16)));
typedef short bf16x8 __attribute__((ext_vector_type(8)));
typedef short s16x4 __attribute__((ext_vector_type(4)));
typedef unsigned u32x4 __attribute__((ext_vector_type(4)));
typedef unsigned u32x2 __attribute__((ext_vector_type(2)));
typedef float f32x2 __attribute__((ext_vector_type(2)));
typedef int i32x2 __attribute__((ext_vector_type(2)));
constexpr float STAT_Q1 = 8192.f, STAT_S1 = 1.0f / 8192.f, STAT_Q2 = 512.f, STAT_S2 = 1.0f / 512.f;

__device__ __forceinline__ float bf2f(unsigned short b) { return __uint_as_float(((unsigned)b) << 16); }
__device__ __forceinline__ unsigned f2bf(float f) { unsigned u = __float_as_uint(f); return (u + 0x7fffu + ((u >> 16) & 1u)) >> 16; }
__device__ __forceinline__ unsigned pk2(float lo, float hi) { return pg8::cvt_pk_bf16(lo, hi); }
__device__ __forceinline__ unsigned pk2h(float lo, float hi) { return pg8::cvt_pk_f16(lo, hi); }
typedef _Float16 f16x2 __attribute__((ext_vector_type(2)));
__device__ __forceinline__ float h2f_lo(unsigned u) { return (float)__builtin_bit_cast(f16x2, u)[0]; }
__device__ __forceinline__ float h2f_hi(unsigned u) { return (float)__builtin_bit_cast(f16x2, u)[1]; }
__device__ __forceinline__ float fexp2(float x) { return __builtin_amdgcn_exp2f(x); }
__device__ __forceinline__ float frcp(float x) { return __builtin_amdgcn_rcpf(x); }
template <int FRAC> __device__ __forceinline__ float qfix(float v) { return __builtin_rintf(v * (float)(1 << FRAC)) * (1.0f / (float)(1 << FRAC)); }
__device__ __forceinline__ float sigmoidf_(float x) { return frcp(1.0f + fexp2(-x * LOG2E)); }
__device__ __forceinline__ float siluf_(float x) { return x * sigmoidf_(x); }

__device__ __forceinline__ int lane_id() { int l; asm volatile("v_mbcnt_lo_u32_b32 %0, -1, 0\n\tv_mbcnt_hi_u32_b32 %0, -1, %0" : "=v"(l)); return l; }

#define XB_TMO      128
#define XB_XCNT(j)  (256  + 64 * (j))
#define XB_XSUB(j)  (1280 + 64 * (j))
#define XB_XGEN(j)  (2304 + 64 * (j))
#define XB_TOP      3328
#define XB_TOPGEN   3392
#define XCD_BAR_WORDS 3456
#define XB_SPIN_CAP (1u << 24)
__device__ __forceinline__ unsigned xb_ld(unsigned* p)              { return __hip_atomic_load(p, __ATOMIC_RELAXED, __HIP_MEMORY_SCOPE_AGENT); }
__device__ __forceinline__ unsigned xb_add(unsigned* p, unsigned v) { return __hip_atomic_fetch_add(p, v, __ATOMIC_RELAXED, __HIP_MEMORY_SCOPE_AGENT); }
__device__ __forceinline__ unsigned xb_xcc_id() { return (unsigned)__builtin_amdgcn_s_getreg((3 << 11) | 20) & 0xFu; }
#define XB_SPIN(cond, bar) do { unsigned _sp = 0; while (cond) { __builtin_amdgcn_s_sleep(1); \
    if ((++_sp & 255u) == 0u) { if (xb_ld(&(bar)[XB_TMO])) break; if (_sp > XB_SPIN_CAP) { atomicAdd(&(bar)[XB_TMO], 1u); break; } } } } while (0)
struct XcdBarrier { unsigned* bar; unsigned x; volatile LAS unsigned* st; };
__device__ __forceinline__ XcdBarrier xcd_barrier_post(unsigned* bar, volatile LAS unsigned* st, bool leader) {
    XcdBarrier b; b.bar = bar; b.x = xb_xcc_id(); b.st = st;
    if (leader) (void)xb_add(&bar[XB_XCNT(b.x)], 1u);
    return b;
}
__device__ __forceinline__ void xcd_barrier_complete(unsigned* bar, unsigned x, unsigned& nloc, unsigned& nx) {
    const unsigned G = gridDim.x * gridDim.y * gridDim.z;
    unsigned sum, cnt, mine, sp = 0u;
    for (;;) {
        sum = 0u; cnt = 0u; mine = 0u;
#pragma unroll
        for (unsigned j = 0; j < 16; ++j) { const unsigned c = xb_ld(&bar[XB_XCNT(j)]); sum += c; cnt += (c > 0u) ? 1u : 0u; mine = (j == x) ? c : mine; }
        if (sum == G) break;
        __builtin_amdgcn_s_sleep(1);
        if ((++sp & 255u) == 0u) { if (xb_ld(&bar[XB_TMO])) break; if (sp > XB_SPIN_CAP) { atomicAdd(&bar[XB_TMO], 1u); break; } }
    }
    nloc = mine > 0u ? mine : 1u; nx = cnt > 0u ? cnt : 1u;
}
__device__ __forceinline__ void xcd_barrier(const XcdBarrier& b, bool leader) {
    asm volatile("s_waitcnt vmcnt(0)" ::: "memory");
    __syncthreads();
    if (leader) {
        unsigned* bar = b.bar;
        __builtin_amdgcn_s_waitcnt(0);
        unsigned nloc = b.st[0], nx = b.st[1];
        if (nloc == 0u) { xcd_barrier_complete(bar, b.x, nloc, nx); b.st[0] = nloc; b.st[1] = nx; }
        const unsigned old = xb_add(&bar[XB_XSUB(b.x)], 1u);
        const unsigned gen = old / nloc;
        if (old + 1u == (gen + 1u) * nloc) {
            __builtin_amdgcn_fence(__ATOMIC_RELEASE, "agent");
            asm volatile("s_waitcnt vmcnt(0)" ::: "memory");
            const unsigned og = xb_add(&bar[XB_TOP], 1u);
            const unsigned tg = og / nx;
            if (og + 1u == (tg + 1u) * nx) xb_add(&bar[XB_TOPGEN], 1u);
            else XB_SPIN(xb_ld(&bar[XB_TOPGEN]) == tg, bar);
            __builtin_amdgcn_fence(__ATOMIC_ACQUIRE, "agent");
            xb_add(&bar[XB_XGEN(b.x)], 1u);
            asm volatile("s_waitcnt vmcnt(0)" ::: "memory");
        } else {
            XB_SPIN(xb_ld(&bar[XB_XGEN(b.x)]) == gen, bar);
            __builtin_amdgcn_fence(__ATOMIC_ACQUIRE, "agent");
            asm volatile("s_waitcnt vmcnt(0)" ::: "memory");
        }
    }
    __syncthreads();
}

struct Args {
    const float* xp; const float* xs; const float* ln_in_g; const float* ln_in_b; const float* w_in; const float* lb_logits; const float* hg_norm_g; const float* attn_sink;
    const float* w_a; const float* w_b; const float* w_out; const float* ln1_g; const float* ln1_b; const float* w_ffn_in; const float* w_ffn_out; const float* ln2_g; const float* ln2_b;
    float* out; unsigned char* ws; int ph_lo, ph_hi;
};

__device__ __forceinline__ float wave_sum(float v) {
#pragma unroll
    for (int o = 1; o < 64; o <<= 1) v += __shfl_xor(v, o);
    return v;
}

__device__ __forceinline__ void row_norm(const float* st, int row, float& A, float& B) {
    const int2 si = *(const int2*)(st + 2 * (size_t)row); float2 s; s.x = (float)si.x * STAT_S1; s.y = (float)si.y * STAT_S2;
    const float mean = s.x * (1.0f / DM); const float var = fmaxf(s.y * (1.0f / DM) - mean * mean, 0.f);
    const float rstd = 1.0f / sqrtf(var + LN_EPS); A = rstd; B = -mean * rstd;
}

template <int MAPKIND>
__device__ __forceinline__ int colmap(int n) {
    if (MAPKIND == 1) { if (n >= 6656) { const int t = (n - 6656) >> 8, i = (n - 6656) & 255; return (i < 128) ? (6656 + 128 * t + i) : (8704 + 128 * t + (i - 128)); }
        if (n >= 5120 && n < 6400) { const int hb = n & ~127, p = n & 127, j8 = p >> 3, e = p & 7; return hb + ((e < 4) ? (4 * j8 + e) : (64 + 4 * j8 + (e - 4))); } return n; }
    if (MAPKIND == 2) { const int t = n >> 8, i = n & 255; return (i < 128) ? (128 * t + i) : (DFF + 128 * t + (i - 128)); }
    return n;
}
template <int MAPKIND, bool FOLD>
__device__ __forceinline__ void transpose_item(const float* W, int K, int N, bf16* WT, int ldk, const float* gain, const float* bias, float* c1, float* c2, LAS float* scr, int item, int lane) {
    const int nblk = N / 32, kb = item / nblk, nb = item % nblk, k0 = 64 * kb, n0 = 32 * nb;
    const int ncol = colmap<MAPKIND>(n0 + (lane & 31));
    float s1 = 0.f, s2 = 0.f;
#pragma unroll 8
    for (int i = 0; i < 32; ++i) { const int kk = 2 * i + (lane >> 5); float w = W[(size_t)(k0 + kk) * N + ncol];
        if (FOLD) { const float gk = gain[k0 + kk], bk = bias[k0 + kk]; s2 += bk * w; w *= gk; s1 += __uint_as_float(f2bf(w) << 16); }
        scr[kk * 33 + (lane & 31)] = w; }
    if (FOLD) { s1 += __shfl_xor(s1, 32); s2 += __shfl_xor(s2, 32); if (lane < 32) { atomicAdd(c1 + n0 + lane, qfix<19>(s1)); atomicAdd(c2 + n0 + lane, qfix<21>(s2)); } }
    asm volatile("s_waitcnt lgkmcnt(0)" ::: "memory");
    const int c = lane & 7;
#pragma unroll
    for (int j = 0; j < 4; ++j) { const int n = (lane >> 3) + 8 * j; const LAS float* s = scr + (8 * c) * 33 + n;
        u32x4 o; o.x = pk2(s[0 * 33], s[1 * 33]); o.y = pk2(s[2 * 33], s[3 * 33]); o.z = pk2(s[4 * 33], s[5 * 33]); o.w = pk2(s[6 * 33], s[7 * 33]);
        *(u32x4*)(WT + (size_t)(n0 + n) * ldk + k0 + 8 * c) = o; }
    asm volatile("s_waitcnt lgkmcnt(0)" ::: "memory");
}

__device__ __forceinline__ void convert_layer(const Args& a, int l, LAS unsigned char* lds, int gw, int ngw, int wave, int lane) {
    LAS float* scr = (LAS float*)(lds + wave * 16384);
    unsigned char* wsw = a.ws + WS_W;
    float* cv = (float*)(a.ws + WS_CVEC + (size_t)l * CVEC_LAYER);
    const float* g_in = l == 0 ? a.ln_in_g : a.ln2_g + (size_t)(l - 1) * DM;
    const float* b_in = l == 0 ? a.ln_in_b : a.ln2_b + (size_t)(l - 1) * DM;
    constexpr int I_IN = (DM / 64) * (NPROJ / 32), I_A = (HW / 64) * (DM / 32), I_OUT = (DM / 64) * (DM / 32), I_FIN = (DM / 64) * (NFFN / 32), I_FOUT = (DFF / 64) * (DM / 32);
    constexpr int NITEMS = I_IN + 2 * I_A + I_OUT + I_FIN + I_FOUT;
    for (int it = gw; it < NITEMS; it += ngw) {
        int r = it;
        if (r < I_IN) { transpose_item<1, true>(a.w_in + (size_t)l * DM * NPROJ, DM, NPROJ, (bf16*)(wsw + W_IN), DM, g_in, b_in, cv, cv + NPROJ, scr, r, lane); continue; } r -= I_IN;
        if (r < I_FIN) { transpose_item<2, true>(a.w_ffn_in + (size_t)l * DM * NFFN, DM, NFFN, (bf16*)(wsw + W_FIN), DM, a.ln1_g + (size_t)l * DM, a.ln1_b + (size_t)l * DM, cv + 2 * NPROJ, cv + 2 * NPROJ + NFFN, scr, r, lane); continue; } r -= I_FIN;
        if (r < I_FOUT) { transpose_item<0, false>(a.w_ffn_out + (size_t)l * DFF * DM, DFF, DM, (bf16*)(wsw + W_FOUT), DFF, nullptr, nullptr, nullptr, nullptr, scr, r, lane); continue; } r -= I_FOUT;
        if (r < I_OUT) { transpose_item<0, false>(a.w_out + (size_t)l * DM * DM, DM, DM, (bf16*)(wsw + W_OUT), DM, nullptr, nullptr, nullptr, nullptr, scr, r, lane); continue; } r -= I_OUT;
        if (r < I_A) { transpose_item<0, false>(a.w_a + (size_t)l * HW * DM, HW, DM, (bf16*)(wsw + W_A), DM, nullptr, nullptr, nullptr, nullptr, scr, r, lane); continue; } r -= I_A;
        transpose_item<0, false>(a.w_b + (size_t)l * HW * DM, HW, DM, (bf16*)(wsw + W_A) + HW, DM, nullptr, nullptr, nullptr, nullptr, scr, r, lane);
    }
}

__device__ __forceinline__ const float* xrow_ptr(const Args& a, int m) { return m < NSEQ_P * SEQ_P ? a.xp + (size_t)m * DM : a.xs + (size_t)(m - NSEQ_P * SEQ_P) * DM; }

__device__ __forceinline__ void prologue(const Args& a, int gw, int ngw, int lane) {
    { float* lb = (float*)(a.ws + WS_LB);
      for (int c = gw * 64 + lane; c < 2048; c += ngw * 64) {
          float v[DEPTH], mx = -1e30f, s = 0.f;
#pragma unroll
          for (int l = 0; l < DEPTH; ++l) { v[l] = a.lb_logits[l * 2048 + c]; mx = fmaxf(mx, v[l]); }
#pragma unroll
          for (int l = 0; l < DEPTH; ++l) { v[l] = expf(v[l] - mx); s += v[l]; }
          float cum = 0.f;
#pragma unroll
          for (int l = 0; l < DEPTH; ++l) { const float p = v[l] / s; cum += p; lb[l * 2048 + c] = cum - v[0] / s; }
      } }
    { float* ct = (float*)(a.ws + WS_COS); float* st = (float*)(a.ws + WS_SIN);
      for (int i = gw * 64 + lane; i < SEQ_S * 64; i += ngw * 64) { const int pos = i >> 6, j = i & 63;
          const double inv = pow(10000.0, -(double)(2 * j) / 128.0); const double ang = (double)pos * inv; ct[i] = (float)cos(ang); st[i] = (float)sin(ang); } }
    { float* st0 = (float*)(a.ws + WS_STATS); bf16* ybf = (bf16*)(a.ws + WS_YBF);
      for (int m = gw; m < MTOK; m += ngw) {
          const f32x4* xr = (const f32x4*)xrow_ptr(a, m) + lane; float s = 0.f, s2 = 0.f;
          unsigned long long* o8 = (unsigned long long*)(ybf + (size_t)m * DM) + lane;
#pragma unroll
          for (int j = 0; j < 8; ++j) { const f32x4 v = xr[64 * j]; s += (v.x + v.y) + (v.z + v.w); s2 += (v.x * v.x + v.y * v.y) + (v.z * v.z + v.w * v.w);
              o8[64 * j] = (unsigned long long)pk2(v.x, v.y) | ((unsigned long long)pk2(v.z, v.w) << 32); }
          s = wave_sum(s); s2 = wave_sum(s2);
          if (lane == 0) { ((int*)st0)[2 * (size_t)m] = (int)rintf(s * STAT_Q1); ((int*)st0)[2 * (size_t)m + 1] = (int)rintf(s2 * STAT_Q2); }
      } }
}

typedef pg8::f32x4 (&AccRef)[2][2][4][2];
template <class T> __device__ __forceinline__ T ldg(const void* base, unsigned off) { return *(const GAS T*)((const GAS char*)base + off); }
template <class T> __device__ __forceinline__ void stg(void* base, unsigned off, T v) { *(GAS T*)((GAS char*)base + off) = v; }
__device__ __forceinline__ void row_norm_o(const float* st, unsigned off8, float& A, float& B) {
    const i32x2 si = ldg<i32x2>(st, off8); f32x2 s; s.x = (float)si.x * STAT_S1; s.y = (float)si.y * STAT_S2;
    const float mean = s.x * (1.0f / DM); const float var = fmaxf(s.y * (1.0f / DM) - mean * mean, 0.f);
    const float rstd = 1.0f / sqrtf(var + LN_EPS); A = rstd; B = -mean * rstd;
}

__device__ __forceinline__ void load_row_norms(const float* st, int row0, float (&A)[8], float (&B)[8]) {
    i32x2 sv[8];
#pragma unroll
    for (int i = 0; i < 8; ++i) sv[i] = ldg<i32x2>(st, (unsigned)((row0 + (i >> 2) * 128 + (i & 3) * 16) * 8));
#pragma unroll
    for (int i = 0; i < 8; ++i) { const float mean = (float)sv[i].x * (STAT_S1 / DM); const float var = fmaxf((float)sv[i].y * (STAT_S2 / DM) - mean * mean, 0.f);
        const float rstd = 1.0f / sqrtf(var + LN_EPS); A[i] = rstd; B[i] = -mean * rstd; }
}

struct EpiProj {
    static constexpr bool PERM = true, HAS_MID = false, F16 = false;
    unsigned char* ws; const float* stats; const float* c1; const float* c2; const float* lb;
    __device__ __forceinline__ void operator()(AccRef acc, const pg8::Unit& u, int wr, int wc, int fr, int fq) const {
        const int pn = u.pn, row0 = u.pm * 256 + wr * 64 + fr, cl = wc * 32 + 8 * fq, colg = pn * 256 + cl;
        int type, ldc, dcol; size_t dbase;
        if (pn < 4)       { type = 0; dbase = P_HQ;  ldc = HW;  dcol = pn * 256; }
        else if (pn < 8)  { type = 1; dbase = P_GF;  ldc = HW;  dcol = (pn - 4) * 256; }
        else if (pn < 12) { type = 1; dbase = P_GB;  ldc = HW;  dcol = (pn - 8) * 256; }
        else if (pn < 16) { type = 2; dbase = P_HI;  ldc = HW;  dcol = (pn - 12) * 256; }
        else if (pn < 20) { type = 0; dbase = P_HG;  ldc = HW;  dcol = (pn - 16) * 256; }
        else if (pn < 24) { type = 3; dbase = P_AQ;  ldc = HW;  dcol = (pn - 20) * 256; }
        else if (pn < 25) { type = 4; dbase = P_AK;  ldc = KVW; dcol = 0; }
        else if (pn < 26) { type = 2; dbase = P_AV;  ldc = KVW; dcol = 0; }
        else              { type = 5; dbase = P_GA;  ldc = DM;  dcol = (pn - 26) * 128; }
        unsigned char* dst = ws + dbase;
        const unsigned doff0 = (unsigned)((row0 * ldc + dcol + cl) * 2), dstep = (unsigned)(16 * ldc * 2);
        const int pos0 = (u.pm < 128 ? ((u.pm & 7) * 256) : ((u.pm - 128) * 256)) + wr * 64 + fr;
        const unsigned roff0 = (unsigned)(pos0 * 256 + (16 * wc + 4 * fq) * 4);
        const float* cost = (const float*)(ws + WS_COS); const float* sint = (const float*)(ws + WS_SIN);
        float A[8], B[8]; load_row_norms(stats, row0, A, B);
        if (type == 5) {
            unsigned char* dstb = ws + P_GBB;
            pg8::f32x4 c1v[2][2], c2v[2][2];
#pragma unroll
            for (int bj = 0; bj < 2; ++bj)
#pragma unroll
                for (int n = 0; n < 2; ++n) { c1v[bj][n] = ldg<pg8::f32x4>(c1, (unsigned)((colg + bj * 128 + 4 * n) * 4)); c2v[bj][n] = ldg<pg8::f32x4>(c2, (unsigned)((colg + bj * 128 + 4 * n) * 4)) * (-LOG2E); }
            asm volatile("" ::: "memory");
#pragma unroll
            for (int ai = 0; ai < 2; ++ai)
#pragma unroll
                for (int m = 0; m < 4; ++m) {
                    const float Ar = -LOG2E * A[ai * 4 + m], Br = -LOG2E * B[ai * 4 + m];
                    float rt[8], gb[8];
#pragma unroll
                    for (int n = 0; n < 2; ++n)
#pragma unroll
                        for (int j = 0; j < 4; ++j) {
                            const float xa = __builtin_fmaf(acc[ai][0][m][n][j], Ar, __builtin_fmaf(c1v[0][n][j], Br, c2v[0][n][j])), xb = __builtin_fmaf(acc[ai][1][m][n][j], Ar, __builtin_fmaf(c1v[1][n][j], Br, c2v[1][n][j]));
                            const float ea = 1.0f + fexp2(fminf(xa, 80.f)), eb = 1.0f + fexp2(fminf(xb, 80.f)); gb[4 * n + j] = frcp(eb); rt[4 * n + j] = eb * frcp(ea); }
                    u32x4 wr_, wg_; wr_.x = pk2(rt[0], rt[1]); wr_.y = pk2(rt[2], rt[3]); wr_.z = pk2(rt[4], rt[5]); wr_.w = pk2(rt[6], rt[7]);
                    wg_.x = pk2(gb[0], gb[1]); wg_.y = pk2(gb[2], gb[3]); wg_.z = pk2(gb[4], gb[5]); wg_.w = pk2(gb[6], gb[7]);
                    const unsigned o = doff0 + (unsigned)(ai * 8 + m) * dstep;
                    stg<u32x4>(dst, o, wr_); stg<u32x4>(dstb, o, wg_);
                }
            return;
        }
#pragma unroll
        for (int bj = 0; bj < 2; ++bj) {
            pg8::f32x4 c1v[2], c2v[2], lbv[2];
#pragma unroll
            for (int n = 0; n < 2; ++n) { c1v[n] = ldg<pg8::f32x4>(c1, (unsigned)((colg + bj * 128 + 4 * n) * 4)); c2v[n] = ldg<pg8::f32x4>(c2, (unsigned)((colg + bj * 128 + 4 * n) * 4));
                lbv[n] = (type == 1) ? ldg<pg8::f32x4>(lb, (unsigned)(((pn - 4) * 256 + cl + bj * 128 + 4 * n) * 4)) : (pg8::f32x4){0.f, 0.f, 0.f, 0.f}; }
            asm volatile("" ::: "memory");
#pragma unroll
            for (int ai = 0; ai < 2; ++ai) {
                pg8::f32x4 cs[4], sn[4];
                if (type == 3 || type == 4) {
#pragma unroll
                    for (int m = 0; m < 4; ++m) { cs[m] = ldg<pg8::f32x4>(cost, roff0 + (unsigned)((ai * 128 + m * 16) * 256)); sn[m] = ldg<pg8::f32x4>(sint, roff0 + (unsigned)((ai * 128 + m * 16) * 256)); }
                    asm volatile("" ::: "memory");
                }
#pragma unroll
                for (int m = 0; m < 4; ++m) {
                    const float Ar = A[ai * 4 + m], Br = B[ai * 4 + m];
                    pg8::f32x4 v[2];
#pragma unroll
                    for (int n = 0; n < 2; ++n)
#pragma unroll
                        for (int j = 0; j < 4; ++j) v[n][j] = __builtin_fmaf(acc[ai][bj][m][n][j], Ar, __builtin_fmaf(c1v[n][j], Br, c2v[n][j]));
                    if (type == 0) {
#pragma unroll
                        for (int n = 0; n < 2; ++n)
#pragma unroll
                            for (int j = 0; j < 4; ++j) v[n][j] = v[n][j] * frcp(1.0f + fexp2(v[n][j] * -LOG2E));
                    } else if (type == 1) {
#pragma unroll
                        for (int n = 0; n < 2; ++n)
#pragma unroll
                            for (int j = 0; j < 4; ++j) { const float lbx = lbv[n][j]; const float f = __builtin_fmaf(1.0f - lbx, frcp(1.0f + fexp2(v[n][j] * -LOG2E)), lbx); v[n][j] = __builtin_amdgcn_logf(fmaxf(f, 1e-30f)); }
                    } else if (type == 3 || type == 4) {
                        const float sc = type == 3 ? QSCALE : 1.0f;
                        const pg8::f32x4 x1 = v[0], x2 = v[1]; v[0] = (x1 * cs[m] - x2 * sn[m]) * sc; v[1] = (x2 * cs[m] + x1 * sn[m]) * sc;
                    }
                    u32x4 w; w.x = pk2(v[0][0], v[0][1]); w.y = pk2(v[0][2], v[0][3]); w.z = pk2(v[1][0], v[1][1]); w.w = pk2(v[1][2], v[1][3]);
                    stg<u32x4>(dst, doff0 + (unsigned)(ai * 8 + m) * dstep + bj * 256, w);
                }
            }
        }
    }
};

struct EpiMergeF {
    static constexpr bool PERM = true, HAS_MID = true, F16 = false;
    const bf16* ratio; const bf16* gateb; bf16* merged;
    __device__ __forceinline__ void mid(AccRef acc, const pg8::Unit& u, int wr, int wc, int fr, int fq) const {
        const int row0 = u.pm * 256 + wr * 64 + fr, col0 = u.pn * 256 + wc * 32 + 8 * fq;
        const unsigned off0 = (unsigned)((row0 * DM + col0) * 2);
#pragma unroll
        for (int ai = 0; ai < 2; ++ai) {
            u32x4 gv[4][2];
#pragma unroll
            for (int m = 0; m < 4; ++m)
#pragma unroll
                for (int bj = 0; bj < 2; ++bj) gv[m][bj] = ldg<u32x4>(ratio, off0 + (unsigned)((ai * 128 + m * 16) * DM * 2) + bj * 256);
            asm volatile("" ::: "memory");
#pragma unroll
            for (int m = 0; m < 4; ++m)
#pragma unroll
                for (int bj = 0; bj < 2; ++bj)
#pragma unroll
                    for (int j = 0; j < 8; ++j) { const unsigned gw_ = gv[m][bj][j >> 1]; const float gg = (j & 1) ? __uint_as_float(gw_ & 0xffff0000u) : __uint_as_float(gw_ << 16); acc[ai][bj][m][j >> 2][j & 3] *= gg; }
        }
    }
    __device__ __forceinline__ void operator()(AccRef acc, const pg8::Unit& u, int wr, int wc, int fr, int fq) const {
        const int row0 = u.pm * 256 + wr * 64 + fr, col0 = u.pn * 256 + wc * 32 + 8 * fq;
        const unsigned off0 = (unsigned)((row0 * DM + col0) * 2);
#pragma unroll
        for (int ai = 0; ai < 2; ++ai) {
            u32x4 gv[4][2];
#pragma unroll
            for (int m = 0; m < 4; ++m)
#pragma unroll
                for (int bj = 0; bj < 2; ++bj) gv[m][bj] = ldg<u32x4>(gateb, off0 + (unsigned)((ai * 128 + m * 16) * DM * 2) + bj * 256);
            asm volatile("" ::: "memory");
#pragma unroll
            for (int m = 0; m < 4; ++m)
#pragma unroll
                for (int bj = 0; bj < 2; ++bj) { float r[8];
#pragma unroll
                    for (int j = 0; j < 8; ++j) { const unsigned gw_ = gv[m][bj][j >> 1]; const float gg = (j & 1) ? __uint_as_float(gw_ & 0xffff0000u) : __uint_as_float(gw_ << 16); r[j] = gg * acc[ai][bj][m][j >> 2][j & 3]; }
                    u32x4 w; w.x = pk2(r[0], r[1]); w.y = pk2(r[2], r[3]); w.z = pk2(r[4], r[5]); w.w = pk2(r[6], r[7]);
                    stg<u32x4>(merged, off0 + (unsigned)((ai * 128 + m * 16) * DM * 2) + bj * 256, w); }
        }
    }
};

template <int SRC> struct EpiResid {
    static constexpr bool PERM = true, HAS_MID = false, F16 = false;
    const float* srcp; const float* srcs; const unsigned short* y16src;
    const float* stats_in; const float* g; const float* b; unsigned short* y16dst; bf16* ybfdst; float* y32dst; float* stats_out;
    __device__ __forceinline__ void operator()(AccRef acc, const pg8::Unit& u, int wr, int wc, int fr, int fq) const {
        const int row0 = u.pm * 256 + wr * 64 + fr, col0 = u.pn * 256 + wc * 32 + 8 * fq;
        const bool samp = u.pm >= 128;
        const float* src = samp ? srcs : srcp;
        const unsigned yoff0 = (unsigned)((row0 * DM + col0) * 2);
        const unsigned xoff0 = samp ? 2 * yoff0 - (unsigned)(NSEQ_P * SEQ_P) * DM * 4u : 2 * yoff0;
        float A[8], B[8]; load_row_norms(stats_in, row0, A, B);
        float ssum[8], ssq[8];
#pragma unroll
        for (int i = 0; i < 8; ++i) { ssum[i] = 0.f; ssq[i] = 0.f; }
#pragma unroll
        for (int bj = 0; bj < 2; ++bj) {
            pg8::f32x4 gv[2], bv[2];
#pragma unroll
            for (int n = 0; n < 2; ++n) { gv[n] = ldg<pg8::f32x4>(g, (unsigned)((col0 + bj * 128 + 4 * n) * 4)) * ALPHA; bv[n] = ldg<pg8::f32x4>(b, (unsigned)((col0 + bj * 128 + 4 * n) * 4)) * ALPHA; }
#pragma unroll
            for (int ai = 0; ai < 2; ++ai) {
                pg8::f32x4 yv[4][2];
                if (SRC == 0) {
#pragma unroll
                    for (int m = 0; m < 4; ++m)
#pragma unroll
                        for (int n = 0; n < 2; ++n) yv[m][n] = ldg<pg8::f32x4>(src, xoff0 + (unsigned)((ai * 128 + m * 16) * DM * 4) + bj * 512 + 16 * n);
                } else {
                    u32x4 raw[4];
#pragma unroll
                    for (int m = 0; m < 4; ++m) raw[m] = ldg<u32x4>(y16src, yoff0 + (unsigned)((ai * 128 + m * 16) * DM * 2) + bj * 256);
#pragma unroll
                    for (int m = 0; m < 4; ++m)
#pragma unroll
                        for (int n = 0; n < 2; ++n) yv[m][n] = (pg8::f32x4){h2f_lo(raw[m][2 * n]), h2f_hi(raw[m][2 * n]), h2f_lo(raw[m][2 * n + 1]), h2f_hi(raw[m][2 * n + 1])};
                }
                asm volatile("" ::: "memory");
#pragma unroll
                for (int m = 0; m < 4; ++m) {
                    const float Ar = A[ai * 4 + m], Br = B[ai * 4 + m]; const unsigned yoff = yoff0 + (unsigned)((ai * 128 + m * 16) * DM * 2) + bj * 256;
                    pg8::f32x4 o[2];
#pragma unroll
                    for (int n = 0; n < 2; ++n) { o[n] = ((yv[m][n] * Ar + Br) * gv[n] + bv[n]) + acc[ai][bj][m][n];
                        ssum[ai * 4 + m] += (o[n][0] + o[n][1]) + (o[n][2] + o[n][3]); ssq[ai * 4 + m] += (o[n][0] * o[n][0] + o[n][1] * o[n][1]) + (o[n][2] * o[n][2] + o[n][3] * o[n][3]); }
                    if (y32dst) { stg<pg8::f32x4>(y32dst, 2 * yoff, o[0]); stg<pg8::f32x4>(y32dst, 2 * yoff + 16, o[1]); }
                    if (y16dst) { u32x4 w; w.x = pk2h(o[0][0], o[0][1]); w.y = pk2h(o[0][2], o[0][3]); w.z = pk2h(o[1][0], o[1][1]); w.w = pk2h(o[1][2], o[1][3]); stg<u32x4>(y16dst, yoff, w); }
                    if (ybfdst) { u32x4 w; w.x = pk2(o[0][0], o[0][1]); w.y = pk2(o[0][2], o[0][3]); w.z = pk2(o[1][0], o[1][1]); w.w = pk2(o[1][2], o[1][3]); stg<u32x4>(ybfdst, yoff, w); }
                }
                asm volatile("" ::: "memory");
            }
        }
#pragma unroll
        for (int i = 0; i < 8; ++i) { float s = ssum[i], s2 = ssq[i];
            s += __shfl_xor(s, 16); s += __shfl_xor(s, 32); s2 += __shfl_xor(s2, 16); s2 += __shfl_xor(s2, 32);
            const unsigned soff = (unsigned)((row0 + (i >> 2) * 128 + (i & 3) * 16) * 8);
            const int iv = (fq == 0) ? (int)rintf(s * STAT_Q1) : (int)rintf(s2 * STAT_Q2);
            if (fq < 2) atomicAdd((int*)((char*)stats_out + soff + 4 * fq), iv); }
    }
};

struct EpiSwiglu {
    static constexpr bool PERM = true, HAS_MID = false, F16 = false;
    const float* stats; const float* c1; const float* c2; bf16* hid;
    __device__ __forceinline__ void operator()(AccRef acc, const pg8::Unit& u, int wr, int wc, int fr, int fq) const {
        const int row0 = u.pm * 256 + wr * 64 + fr, cl = wc * 32 + 8 * fq, colg = u.pn * 256 + cl;
        float A[8], B[8]; load_row_norms(stats, row0, A, B);
        pg8::f32x4 c1v[2][2], c2v[2][2];
#pragma unroll
        for (int bj = 0; bj < 2; ++bj)
#pragma unroll
            for (int n = 0; n < 2; ++n) { c1v[bj][n] = ldg<pg8::f32x4>(c1, (unsigned)((colg + bj * 128 + 4 * n) * 4)); c2v[bj][n] = ldg<pg8::f32x4>(c2, (unsigned)((colg + bj * 128 + 4 * n) * 4)); }
        asm volatile("" ::: "memory");
        const unsigned hoff0 = (unsigned)((row0 * DFF + u.pn * 128 + cl) * 2);
#pragma unroll
        for (int ai = 0; ai < 2; ++ai)
#pragma unroll
            for (int m = 0; m < 4; ++m) {
                const float Ar = A[ai * 4 + m], Br = B[ai * 4 + m];
                float r[8];
#pragma unroll
                for (int n = 0; n < 2; ++n)
#pragma unroll
                    for (int j = 0; j < 4; ++j) { const float gt = __builtin_fmaf(acc[ai][0][m][n][j], Ar, __builtin_fmaf(c1v[0][n][j], Br, c2v[0][n][j])), up = __builtin_fmaf(acc[ai][1][m][n][j], Ar, __builtin_fmaf(c1v[1][n][j], Br, c2v[1][n][j]));
                        r[4 * n + j] = gt * up * frcp(1.0f + fexp2(gt * -LOG2E)); }
                u32x4 w; w.x = pk2(r[0], r[1]); w.y = pk2(r[2], r[3]); w.z = pk2(r[4], r[5]); w.w = pk2(r[6], r[7]);
                stg<u32x4>(hid, hoff0 + (unsigned)((ai * 128 + m * 16) * DFF * 2), w);
            }
    }
};

__device__ __forceinline__ unsigned off_b(unsigned row, unsigned ch) { return 256u * row + 16u * (ch ^ (((row & 3) << 2) | ((row >> 2) & 3))); }
__device__ __forceinline__ bf16x8 frag_row(const LAS unsigned char* img, int r0, int ks, int lane) { return *(const LAS bf16x8*)(img + off_b(r0 + (lane & 31), 2 * ks + (lane >> 5))); }
__device__ __forceinline__ bf16x8 frag_tr(const LAS unsigned char* img, int k0, int c0, int lane) {
    const unsigned h = lane >> 5, blk = (lane >> 4) & 1, q = (lane & 15) >> 2, p = lane & 3;
    const unsigned ch = (unsigned)(c0 >> 3) + 2 * blk + (p >> 1);
    const s16x4 lo = __builtin_amdgcn_ds_read_tr16_b64_v4i16((LAS s16x4*)(img + off_b(k0 + 8 * h + q, ch) + 8 * (p & 1)));
    const s16x4 hi = __builtin_amdgcn_ds_read_tr16_b64_v4i16((LAS s16x4*)(img + off_b(k0 + 8 * h + 4 + q, ch) + 8 * (p & 1)));
    return (bf16x8){lo[0], lo[1], lo[2], lo[3], hi[0], hi[1], hi[2], hi[3]};
}
__device__ __forceinline__ bf16x8 frag_tr_acc(const LAS unsigned char* img, int k0, int c0, int lane) {
    const unsigned h = lane >> 5, blk = (lane >> 4) & 1, q = (lane & 15) >> 2, p = lane & 3;
    const unsigned ch = (unsigned)(c0 >> 3) + 2 * blk + (p >> 1);
    const s16x4 lo = __builtin_amdgcn_ds_read_tr16_b64_v4i16((LAS s16x4*)(img + off_b(k0 + 4 * h + q, ch) + 8 * (p & 1)));
    const s16x4 hi = __builtin_amdgcn_ds_read_tr16_b64_v4i16((LAS s16x4*)(img + off_b(k0 + 8 + 4 * h + q, ch) + 8 * (p & 1)));
    return (bf16x8){lo[0], lo[1], lo[2], lo[3], hi[0], hi[1], hi[2], hi[3]};
}
__device__ __forceinline__ int crow(int r, int h) { return (r & 3) + 8 * (r >> 2) + 4 * h; }
#define MFMA32(A, B, C) __builtin_amdgcn_mfma_f32_32x32x16_bf16((A), (B), (C), 0, 0, 0)

constexpr int SC_RQ = 0, SC_RG = 16384, SC_VI = 32768, SC_SI = 49152, SC_QT = 81920, SC_KT = 100352, SC_AI = 118784, SC_EM = 128000, SC_EE = 128512, SC_EME = 129024, SC_END = 129536;
constexpr int T_STR = 144, AI_STR = 144;
static_assert(SC_END <= RING_BYTES, "scan LDS");
__device__ __forceinline__ bf16x8 frag_tr144(const LAS unsigned char* img, int k0, int c0, int lane) {
    const unsigned h = lane >> 5, blk = (lane >> 4) & 1, q = (lane & 15) >> 2, p = lane & 3;
    const LAS unsigned char* ad = img + (k0 + 8 * h + q) * T_STR + (c0 + 16 * blk + 4 * p) * 2;
    const s16x4 lo = __builtin_amdgcn_ds_read_tr16_b64_v4i16((LAS s16x4*)ad);
    const s16x4 hi = __builtin_amdgcn_ds_read_tr16_b64_v4i16((LAS s16x4*)(ad + 4 * T_STR));
    return (bf16x8){lo[0], lo[1], lo[2], lo[3], hi[0], hi[1], hi[2], hi[3]};
}
constexpr int SC_BEL = 129536;
static_assert(SC_BEL + 512 <= RING_BYTES, "scan LDS");
template <int MODE>
__device__ __forceinline__ void scan_unit(const Args& a, LAS unsigned char* lds, int rowbase, int head, int dir, int seg, int tid, int wave, int lane) {
    constexpr int L = SEQ_P; constexpr int mode = MODE;
    const unsigned char* hq = a.ws + P_HQ; const unsigned char* gg = a.ws + (dir ? P_GB : P_GF); const unsigned char* hv = a.ws + P_HI;
    unsigned char* oraw = a.ws + (dir ? WS_OBWD : WS_AOUT);
    LAS unsigned char* RQ = lds + SC_RQ; LAS unsigned char* RG = lds + SC_RG; LAS unsigned char* VI = lds + SC_VI; LAS unsigned char* SI = lds + SC_SI;
    LAS unsigned char* QT = lds + SC_QT; LAS unsigned char* KT = lds + SC_KT; LAS unsigned char* AI = lds + SC_AI;
    LAS float* em = (LAS float*)(lds + SC_EM); LAS float* ee = (LAS float*)(lds + SC_EE); LAS float* eme = (LAS float*)(lds + SC_EME); LAS float* bel = (LAS float*)(lds + SC_BEL);
    const int h = lane >> 5, l31 = lane & 31, blk = (lane >> 4) & 1, q4 = (lane & 15) >> 2, p = lane & 3;
    const int tb = wave >> 2, kb = wave & 3;
    constexpr bool passA = MODE == 1;
    bf16x8 Ld[2], Lone;
#pragma unroll
    for (int ksl = 0; ksl < 2; ++ksl)
#pragma unroll
        for (int j = 0; j < 8; ++j) Ld[ksl][j] = (16 * ksl + 8 * h + j <= l31) ? (short)0x3F80 : (short)0;
#pragma unroll
    for (int j = 0; j < 8; ++j) Lone[j] = (short)0x3F80;
    const int kk0 = 32 * ((2 * wave) & 3) + l31, kk1 = 32 * ((2 * wave + 1) & 3) + l31;
    f32x16 S0, S1;
#pragma unroll
    for (int r = 0; r < 16; ++r) { S0[r] = 0.f; S1[r] = 0.f; }
    float dlog0 = 0.f, dlog1 = 0.f;
    if (mode == 2) {
        const int nprev = dir ? (3 - seg) : seg;
        for (int i = 0; i < nprev; ++i) { const int sg = dir ? (3 - i) : i; const int slot = (sg * 8 + head) * 2 + dir;
            const float* E = (const float*)(a.ws + WS_SEGE) + ((size_t)slot * 512 + tid) * 32; const float* D = (const float*)(a.ws + WS_SEGD) + slot * 128;
            const float d0 = fexp2(D[kk0]), d1 = fexp2(D[kk1]);
#pragma unroll
            for (int r4 = 0; r4 < 4; ++r4) { const f32x4 e0 = *(const f32x4*)(E + 4 * r4), e1 = *(const f32x4*)(E + 16 + 4 * r4);
#pragma unroll
                for (int j = 0; j < 4; ++j) { S0[4 * r4 + j] = S0[4 * r4 + j] * d0 + e0[j]; S1[4 * r4 + j] = S1[4 * r4 + j] * d1 + e1[j]; } } }
    }
    constexpr int nch = L / 64;
    u32x4 pq[2], pg[2], pv[2];
    const unsigned colb = (unsigned)((head * 128 + (tid & 15) * 8) * 2);
    auto chunk_off = [&](int cc, int e) -> unsigned { const int c0 = dir ? (L - 64 * (cc + 1)) : 64 * cc; const int i = (tid >> 4) + 32 * e; const int t = dir ? (c0 + 63 - i) : (c0 + i);
        return (unsigned)(rowbase + t) * (unsigned)(HW * 2) + colb; };
#pragma unroll
    for (int e = 0; e < 2; ++e) { const unsigned o = chunk_off(0, e); pq[e] = passA ? (u32x4){0u, 0u, 0u, 0u} : ldg<u32x4>(hq, o); pg[e] = ldg<u32x4>(gg, o); pv[e] = ldg<u32x4>(hv, o); }
    for (int cc = 0; cc < nch; ++cc) {
        const int c0 = dir ? (L - 64 * (cc + 1)) : 64 * cc;
#pragma unroll
        for (int e = 0; e < 2; ++e) { const unsigned ob = off_b((tid >> 4) + 32 * e, tid & 15); *(LAS u32x4*)(RQ + ob) = pq[e]; *(LAS u32x4*)(RG + ob) = pg[e]; *(LAS u32x4*)(VI + ob) = pv[e]; }
        if (cc + 1 < nch) {
#pragma unroll
            for (int e = 0; e < 2; ++e) { const unsigned o = chunk_off(cc + 1, e); if (!passA) pq[e] = ldg<u32x4>(hq, o); pg[e] = ldg<u32x4>(gg, o); pv[e] = ldg<u32x4>(hv, o); }
        }
        __syncthreads();
        { s16x4 graw[4], qraw[4];
#pragma unroll
          for (int g4 = 0; g4 < 4; ++g4) { const unsigned ad = off_b(32 * tb + 8 * g4 + 4 * h + q4, 4 * kb + 2 * blk + (p >> 1)) + 8 * (p & 1);
              graw[g4] = __builtin_amdgcn_ds_read_tr16_b64_v4i16((LAS s16x4*)(RG + ad)); qraw[g4] = __builtin_amdgcn_ds_read_tr16_b64_v4i16((LAS s16x4*)(RQ + ad)); }
          f32x16 c;
#pragma unroll
          for (int r = 0; r < 16; ++r) c[r] = 0.f;
          float bmid, bend = 0.f;
          if (tb == 0) { c = MFMA32(Ld[0], frag_tr(RG, 0, 32 * kb, lane), c); c = MFMA32(Ld[1], frag_tr(RG, 16, 32 * kb, lane), c); bmid = __shfl(c[15], l31 + 32); }
          else { c = MFMA32(Lone, frag_tr(RG, 0, 32 * kb, lane), c); c = MFMA32(Lone, frag_tr(RG, 16, 32 * kb, lane), c); bmid = c[0];
                 c = MFMA32(Ld[0], frag_tr(RG, 32, 32 * kb, lane), c); c = MFMA32(Ld[1], frag_tr(RG, 48, 32 * kb, lane), c); bend = __shfl(c[15], l31 + 32); }
          const int kk = 32 * kb + l31;
#pragma unroll
          for (int g4 = 0; g4 < 4; ++g4) { float qs[4], ks[4];
#pragma unroll
              for (int j = 0; j < 4; ++j) { const float gv = bf2f((unsigned short)graw[g4][j]), qv = bf2f((unsigned short)qraw[g4][j]); const float x = c[4 * g4 + j] - bmid;
                  qs[j] = qv * fexp2(fminf(x, 100.f)); ks[j] = (1.0f - fexp2(gv)) * fexp2(fminf(-x, 100.f)); }
              const unsigned ad = (unsigned)(kk * T_STR + (32 * tb + 8 * g4 + 4 * h) * 2);
              u32x2 wq, wk; wq.x = pk2(qs[0], qs[1]); wq.y = pk2(qs[2], qs[3]); wk.x = pk2(ks[0], ks[1]); wk.y = pk2(ks[2], ks[3]);
              *(LAS u32x2*)(QT + ad) = wq; *(LAS u32x2*)(KT + ad) = wk; }
          if (tb == 1 && h == 0) { em[kk] = fexp2(bmid); ee[kk] = fexp2(bend); eme[kk] = fexp2(bend - bmid); bel[kk] = bend; } }
        __syncthreads();
        if (!passA) {
#pragma unroll
        for (int e = 0; e < 2; ++e) { const int id = 2 * wave + e, vb2 = id >> 2, kk = e ? kk1 : kk0; const float emk = em[kk];
#pragma unroll
            for (int g4 = 0; g4 < 4; ++g4) { const f32x16& S = e ? S1 : S0; u32x2 w; w.x = pk2(S[4 * g4] * emk, S[4 * g4 + 1] * emk); w.y = pk2(S[4 * g4 + 2] * emk, S[4 * g4 + 3] * emk);
                *(LAS u32x2*)(SI + off_b(kk, 4 * vb2 + g4) + 8 * h) = w; } }
        if (wave < 3) { const int sb = wave == 2 ? 1 : 0, tbm = wave == 0 ? 0 : 1; f32x16 c;
#pragma unroll
            for (int r = 0; r < 16; ++r) c[r] = 0.f;
            { bf16x8 ka = frag_tr144(KT, 0, 32 * sb, lane), qa = frag_tr144(QT, 0, 32 * tbm, lane);
#pragma unroll
              for (int ks = 0; ks < 8; ++ks) { bf16x8 kn = ka, qn = qa;
                  if (ks < 7) { kn = frag_tr144(KT, 16 * (ks + 1), 32 * sb, lane); qn = frag_tr144(QT, 16 * (ks + 1), 32 * tbm, lane); }
                  c = MFMA32(ka, qa, c); ka = kn; qa = qn; } }
            const int t = 32 * tbm + l31;
#pragma unroll
            for (int g4 = 0; g4 < 4; ++g4) { float x[4];
#pragma unroll
                for (int j = 0; j < 4; ++j) { const int sx = 32 * sb + 8 * g4 + 4 * h + j; x[j] = (sx <= t) ? c[4 * g4 + j] : 0.f; }
                u32x2 w; w.x = pk2(x[0], x[1]); w.y = pk2(x[2], x[3]); *(LAS u32x2*)(AI + t * AI_STR + (32 * sb + 8 * g4 + 4 * h) * 2) = w; } }
        }
#pragma unroll
        for (int e = 0; e < 2; ++e) { const int id = 2 * wave + e, vb2 = id >> 2, kk = e ? kk1 : kk0; f32x16 c;
#pragma unroll
            for (int r = 0; r < 16; ++r) c[r] = 0.f;
#pragma unroll
            for (int ks = 0; ks < 4; ++ks) c = MFMA32(frag_tr(VI, 16 * ks, 32 * vb2, lane), *(const LAS bf16x8*)(KT + kk * T_STR + (16 * ks + 8 * h) * 2), c);
            const float eek = ee[kk], emek = eme[kk];
            if (e) { dlog1 += bel[kk];
#pragma unroll
                for (int r = 0; r < 16; ++r) S1[r] = S1[r] * eek + c[r] * emek; }
            else { dlog0 += bel[kk];
#pragma unroll
                for (int r = 0; r < 16; ++r) S0[r] = S0[r] * eek + c[r] * emek; } }
        __syncthreads();
        if (!passA) { const int vb = kb; f32x16 c;
#pragma unroll
          for (int r = 0; r < 16; ++r) c[r] = 0.f;
          const LAS unsigned char* aip = AI + (32 * tb + l31) * AI_STR + 16 * h;
          { bf16x8 xa = frag_tr144(QT, 0, 32 * tb, lane), xb = frag_tr(SI, 0, 32 * vb, lane);
#pragma unroll
            for (int ks = 0; ks < 8; ++ks) { bf16x8 na, nb;
                if (ks < 7) { na = frag_tr144(QT, 16 * (ks + 1), 32 * tb, lane); nb = frag_tr(SI, 16 * (ks + 1), 32 * vb, lane); }
                else { na = *(const LAS bf16x8*)aip; nb = frag_tr(VI, 0, 32 * vb, lane); }
                c = MFMA32(xa, xb, c); xa = na; xb = nb; }
            { bf16x8 na = *(const LAS bf16x8*)(aip + 32), nb = frag_tr(VI, 16, 32 * vb, lane); c = MFMA32(xa, xb, c); xa = na; xb = nb; }
            if (tb) { bf16x8 na = *(const LAS bf16x8*)(aip + 64), nb = frag_tr(VI, 32, 32 * vb, lane); c = MFMA32(xa, xb, c); xa = na; xb = nb;
                      na = *(const LAS bf16x8*)(aip + 96); nb = frag_tr(VI, 48, 32 * vb, lane); c = MFMA32(xa, xb, c); xa = na; xb = nb; }
            c = MFMA32(xa, xb, c); }
          const unsigned lo = (unsigned)((head * 128 + 32 * vb + l31) * 2) + (unsigned)((dir ? 4 - 4 * h : 4 * h) * (HW * 2));
          const int tu0 = __builtin_amdgcn_readfirstlane(rowbase + (dir ? c0 + 63 - 32 * tb - 4 : c0 + 32 * tb));
#pragma unroll
          for (int r = 0; r < 16; r += 2) { const unsigned w = pk2(c[r], c[r + 1]);
              const int d0 = (r & 3) + 8 * (r >> 2), d1 = d0 + 1;
              unsigned char* b0 = oraw + (size_t)(unsigned)(dir ? tu0 - d0 : tu0 + d0) * (size_t)(HW * 2); unsigned char* b1 = oraw + (size_t)(unsigned)(dir ? tu0 - d1 : tu0 + d1) * (size_t)(HW * 2);
              stg<unsigned short>(b0, lo, (unsigned short)(w & 0xffffu)); stg<unsigned short>(b1, lo, (unsigned short)(w >> 16)); }
          __syncthreads(); }
    }
    if (passA) {
        const int slot = (seg * 8 + head) * 2 + dir;
        float* E = (float*)(a.ws + WS_SEGE) + ((size_t)slot * 512 + tid) * 32; float* D = (float*)(a.ws + WS_SEGD) + slot * 128;
#pragma unroll
        for (int r4 = 0; r4 < 4; ++r4) { *(f32x4*)(E + 4 * r4) = (f32x4){S0[4 * r4], S0[4 * r4 + 1], S0[4 * r4 + 2], S0[4 * r4 + 3]}; *(f32x4*)(E + 16 + 4 * r4) = (f32x4){S1[4 * r4], S1[4 * r4 + 1], S1[4 * r4 + 2], S1[4 * r4 + 3]}; }
        if (wave < 2 && h == 0) { D[kk0] = dlog0; D[kk1] = dlog1; }
    }
}

__device__ __forceinline__ void finalize_a(const Args& a, int l, int gw, int ngw, int lane, int m_lo, int m_hi) {
    bf16* of = (bf16*)(a.ws + WS_AOUT); const bf16* ob = (const bf16*)(a.ws + WS_OBWD); const bf16* hg = (const bf16*)(a.ws + P_HG);
    const float* ng = a.hg_norm_g + l * 128;
    const int c8 = (lane & 15) * 8;
    float gv[8];
#pragma unroll
    for (int j = 0; j < 8; ++j) gv[j] = ng[c8 + j];
    const unsigned lo = (unsigned)(((lane >> 4) * 128 + c8) * 2);
    struct Rows { u32x4 f[2], b[2], g[2]; };
    auto load = [&](Rows& R, int m) {
#pragma unroll
        for (int p = 0; p < 2; ++p) { const unsigned o = (unsigned)m * (unsigned)(HW * 2) + lo + (unsigned)(p * 1024); R.f[p] = ldg<u32x4>(of, o); R.b[p] = ldg<u32x4>(ob, o); R.g[p] = ldg<u32x4>(hg, o); } };
    auto finish = [&](const Rows& R, int m) {
#pragma unroll
        for (int p = 0; p < 2; ++p) {
            float x[8], ss = 0.f;
#pragma unroll
            for (int j = 0; j < 8; ++j) { const unsigned fw = R.f[p][j >> 1], bw = R.b[p][j >> 1]; const float fv = (j & 1) ? __uint_as_float(fw & 0xffff0000u) : __uint_as_float(fw << 16);
                const float bv = (j & 1) ? __uint_as_float(bw & 0xffff0000u) : __uint_as_float(bw << 16); x[j] = fv + bv; ss += x[j] * x[j]; }
            ss += __shfl_xor(ss, 1); ss += __shfl_xor(ss, 2); ss += __shfl_xor(ss, 4); ss += __shfl_xor(ss, 8);
            const float rs = 1.0f / sqrtf(ss * (1.0f / 128.0f) + RMS_EPS);
            float r[8];
#pragma unroll
            for (int j = 0; j < 8; ++j) { const unsigned gw_ = R.g[p][j >> 1]; const float gt = (j & 1) ? __uint_as_float(gw_ & 0xffff0000u) : __uint_as_float(gw_ << 16); r[j] = x[j] * rs * gv[j] * gt; }
            u32x4 w; w.x = pk2(r[0], r[1]); w.y = pk2(r[2], r[3]); w.z = pk2(r[4], r[5]); w.w = pk2(r[6], r[7]);
            stg<u32x4>(of, (unsigned)m * (unsigned)(HW * 2) + lo + (unsigned)(p * 1024), w); } };
    Rows A, B;
    int m = m_lo + gw;
    if (m < m_hi) load(A, m);
    for (; m < m_hi; m += 2 * ngw) {
        const bool hb = m + ngw < m_hi;
        if (hb) load(B, m + ngw);
        asm volatile("" ::: "memory");
        finish(A, m);
        if (!hb) break;
        if (m + 2 * ngw < m_hi) load(A, m + 2 * ngw);
        asm volatile("" ::: "memory");
        finish(B, m + ngw);
    }
}

constexpr int AT_K = 0, AT_V = 32768, AT_BUF = 65536;
static_assert(2 * AT_BUF <= RING_BYTES, "attention LDS");
__device__ __forceinline__ void attn_unit(const Args& a, int l, LAS unsigned char* lds, int unit, int tid, int wave, int lane) {
    const int nb = unit >> 2, hk = (unit >> 1) & 1, hh = unit & 1;
    int n, N; if (nb < 256) { n = nb & 15; N = 16; } else { n = nb - 256; N = 64; }
    const int qhead = 4 * hk + 2 * hh + (wave >> 2), qt = wave & 3, h = lane >> 5, l31 = lane & 31;
    const bf16* aq = (const bf16*)(a.ws + P_AQ); const unsigned char* ak = a.ws + P_AK; const unsigned char* av = a.ws + P_AV; unsigned char* bo = a.ws + WS_BOUT;
    const int qi = 32 * qt + l31;
    const size_t qrow = (size_t)nb * 128 + qi;
    const int kb_lo = n > 0 ? n - 1 : 0, kb_hi = n + 1 < N ? n + 1 : N - 1;
    auto stage = [&](int kb, int b) {
        const unsigned rowoff = (unsigned)((nb + (kb - n)) * 128) * (unsigned)(KVW * 2) + (unsigned)(hk * 256);
#pragma unroll
        for (int e = 0; e < 4; ++e) { const unsigned row = (unsigned)(e * 32 + (tid >> 4)), ch = (unsigned)(tid & 15) ^ (((row & 3) << 2) | ((row >> 2) & 3));
            const unsigned go = rowoff + row * (unsigned)(KVW * 2) + ch * 16u;
            __builtin_amdgcn_global_load_lds((const GAS unsigned*)((const GAS unsigned char*)ak + go), (LAS unsigned*)(lds + b * AT_BUF + AT_K + e * 8192 + wave * 1024), 16, 0, 0);
            __builtin_amdgcn_global_load_lds((const GAS unsigned*)((const GAS unsigned char*)av + go), (LAS unsigned*)(lds + b * AT_BUF + AT_V + e * 8192 + wave * 1024), 16, 0, 0); } };
    __syncthreads();
    stage(kb_lo, 0);
    bf16x8 qf[8];
#pragma unroll
    for (int ks = 0; ks < 8; ++ks) qf[ks] = *(const bf16x8*)(aq + qrow * HW + qhead * 128 + 16 * ks + 8 * h);
    f32x16 O[4];
#pragma unroll
    for (int c = 0; c < 4; ++c)
#pragma unroll
        for (int r = 0; r < 16; ++r) O[c][r] = 0.f;
    float mrun = a.attn_sink[l * 8 + qhead] * LOG2E, lrun = 1.0f;
    int b = 0;
    for (int kb = kb_lo; kb <= kb_hi; ++kb, b ^= 1) {
        asm volatile("s_waitcnt vmcnt(0)" ::: "memory");
        __syncthreads();
        if (kb < kb_hi) stage(kb + 1, b ^ 1);
        const LAS unsigned char* KI = lds + b * AT_BUF + AT_K; const LAS unsigned char* VI = lds + b * AT_BUF + AT_V;
        const int rel = kb - n;
        for (int kt = 0; kt < 4; ++kt) {
            if ((rel < 0 && kt < qt) || (rel > 0 && kt > qt)) continue;
            f32x16 s;
#pragma unroll
            for (int r = 0; r < 16; ++r) s[r] = 0.f;
#pragma unroll
            for (int ks = 0; ks < 8; ++ks) s = MFMA32(frag_row(KI, 32 * kt, ks, lane), qf[ks], s);
            if (rel != 0 && kt == qt) {
#pragma unroll
                for (int r = 0; r < 16; ++r) { const int jj = 32 * kt + crow(r, h); const bool ok = rel < 0 ? (jj >= qi) : (jj <= qi); s[r] = ok ? s[r] : -__builtin_inff(); } }
            float mx = s[0];
#pragma unroll
            for (int r = 1; r < 16; ++r) mx = fmaxf(mx, s[r]);
            mx = fmaxf(mx, __shfl_xor(mx, 32));
            const float mnew = fmaxf(mrun, mx), alpha = fexp2(mrun - mnew); mrun = mnew;
            float ps = 0.f;
#pragma unroll
            for (int r = 0; r < 16; ++r) { s[r] = fexp2(s[r] - mnew); ps += s[r]; }
            ps += __shfl_xor(ps, 32);
            lrun = lrun * alpha + ps;
            bf16x8 pf[2];
#pragma unroll
            for (int sx = 0; sx < 2; ++sx) { u32x4 w; w.x = pk2(s[8 * sx], s[8 * sx + 1]); w.y = pk2(s[8 * sx + 2], s[8 * sx + 3]); w.z = pk2(s[8 * sx + 4], s[8 * sx + 5]); w.w = pk2(s[8 * sx + 6], s[8 * sx + 7]);
                pf[sx] = __builtin_bit_cast(bf16x8, w); }
            if (__builtin_amdgcn_ballot_w64(alpha != 1.0f) != 0ull) {
#pragma unroll
                for (int c = 0; c < 4; ++c)
#pragma unroll
                    for (int r = 0; r < 16; ++r) O[c][r] *= alpha; }
#pragma unroll
            for (int c = 0; c < 4; ++c)
#pragma unroll
                for (int sx = 0; sx < 2; ++sx) O[c] = MFMA32(frag_tr_acc(VI, 32 * kt + 16 * sx, 32 * c, lane), pf[sx], O[c]);
        }
    }
    const float inv = 1.0f / lrun;
    const unsigned oo = (unsigned)(((unsigned)qrow * HW + qhead * 128 + 4 * h) * 2);
#pragma unroll
    for (int c = 0; c < 4; ++c)
#pragma unroll
        for (int g4 = 0; g4 < 4; ++g4) { u32x2 w; w.x = pk2(O[c][4 * g4] * inv, O[c][4 * g4 + 1] * inv); w.y = pk2(O[c][4 * g4 + 2] * inv, O[c][4 * g4 + 3] * inv);
            stg<u32x2>(bo, oo + (unsigned)((32 * c + 8 * g4) * 2), w); }
}


__device__ __forceinline__ void final_ln(const Args& a, int gw, int ngw, int lane) {
    const float* st = (const float*)(a.ws + WS_STATS + 8 * STATS_BYTES); const float* g = a.ln2_g + 3 * DM; const float* b = a.ln2_b + 3 * DM;
    for (int m = gw; m < MTOK; m += ngw) { float A, B; row_norm(st, m, A, B);
        f32x4* yr = (f32x4*)(a.out + (size_t)m * DM) + lane;
#pragma unroll
        for (int j = 0; j < 8; ++j) { const f32x4 v = yr[64 * j], gv = *((const f32x4*)g + lane + 64 * j), bv = *((const f32x4*)b + lane + 64 * j); yr[64 * j] = (v * A + B) * gv + bv; } }
}

constexpr int N_PHASES = 1 + 8 * DEPTH + 1;
constexpr int FIN_EARLY = 7 * SEQ_P;
#ifndef PH_MASK
#define PH_MASK 0xfff
#endif
#define PHON(j) (((PH_MASK) >> (j)) & 1)
__global__ void __launch_bounds__(NTHREADS, 2) enc_fwd(Args a0) {
    extern __shared__ __attribute__((aligned(16))) unsigned char lds_raw[];
    LAS unsigned char* lds = (LAS unsigned char*)lds_raw;
    volatile LAS unsigned* MISC = (volatile LAS unsigned*)(lds + MISC_OFF);
    const int tid0 = threadIdx.x, wave = __builtin_amdgcn_readfirstlane(tid0 >> 6);
    const int G = gridDim.x, bx = blockIdx.x;
    const int vcu = (G % 8 == 0) ? (bx % 8) * (G / 8) + bx / 8 : bx;
    const int gw = vcu * NWAVES + wave, ngw = G * NWAVES;
    for (int u = tid0; u < (LDS_BYTES - MISC_OFF) / 4; u += NTHREADS) ((LAS unsigned*)(lds + MISC_OFF))[u] = 0u;
    __syncthreads();
    XcdBarrier bar; bar.bar = (unsigned*)(a0.ws + WS_CTL); bar.x = 0; bar.st = nullptr;
#if !MK_PER_PHASE_LAUNCH
    bar = xcd_barrier_post((unsigned*)(a0.ws + WS_CTL), MISC + 8, tid0 == 0);
#endif
    const int lo = a0.ph_lo, hi = a0.ph_hi;
#define IN(k) (lo <= (k) && (k) < hi)
#define LAUNDER() int tid = wave * 64 + lane_id(); asm volatile("" : "+v"(tid)); const int lane = tid & 63; Args a = a0; asm volatile("" : "+s"(a.ws), "+s"(a.out))
#if MK_PER_PHASE_LAUNCH
#define SEAM(k) do { } while (0)
#else
#define SEAM(k) do { if ((k) + 1 < hi) xcd_barrier(bar, wave == 0 && lane_id() == 0); } while (0)
#endif
    if (PHON(8) && IN(0)) { LAUNDER(); prologue(a, gw, ngw, lane); SEAM(0); }

#ifndef PROBE_MIX
#define PROBE_MIX 0
#endif
#if PROBE_MIX
    for (int it_ = 0; it_ < 2 * DEPTH; ++it_) {
        int it = it_; asm volatile("" : "+s"(it)); int l = it >> 1; const int sub = it & 1;
#else
    for (int l_ = 0; l_ < DEPTH; ++l_) {
        int l = l_; asm volatile("" : "+s"(l));
        constexpr int sub = -1;
#endif
        const bool do_scan = sub != 1 || PROBE_MIX != 3, do_attn = sub != 1 || PROBE_MIX != 2, do_fin = sub != 1 || PROBE_MIX != 3;
        const int pb = 1 + 8 * l;
#define LOCALS() LAUNDER(); unsigned char* wsw = a.ws + WS_W; float* cv = (float*)(a.ws + WS_CVEC + (size_t)l * CVEC_LAYER); \
        const float* stats_in = (const float*)(a.ws + WS_STATS + (size_t)(l == 0 ? 0 : 2 * l) * STATS_BYTES); \
        float* stats_1 = (float*)(a.ws + WS_STATS + (size_t)(1 + 2 * l) * STATS_BYTES); float* stats_2 = (float*)(a.ws + WS_STATS + (size_t)(2 + 2 * l) * STATS_BYTES); \
        bf16* ybf = (bf16*)(a.ws + WS_YBF); (void)wsw; (void)cv; (void)stats_in; (void)stats_1; (void)stats_2; (void)ybf
        if (sub != 1 && PHON(0) && IN(pb + 0)) { LOCALS(); convert_layer(a, l, lds, gw, ngw, wave, lane); SEAM(pb + 0); }
        if (sub != 1 && PHON(1) && IN(pb + 1)) { LOCALS();
            pg8::Gemm g{ybf, nullptr, (const bf16*)(wsw + W_IN), MTOK, NPROJ, DM, DM}; pg8::StaticOrder S; S.init(MTOK, NPROJ, G, bx);
            EpiProj E{a.ws, stats_in, cv, cv + NPROJ, (const float*)(a.ws + WS_LB) + l * 2048};
            pg8::gemm_phase<EpiProj, pg8::StaticOrder>(lds, g, S, E, wave);
            SEAM(pb + 1);
        }
        if (PHON(2) && IN(pb + 2)) { LOCALS();
            if (do_scan) for (int u = bx; u < 256; u += G) {
                if (u < 48) { const int hd = u & 7, dir = (u >> 3) & 1, seg = (u >> 4) + dir; scan_unit<1>(a, lds, NSEQ_P * SEQ_P + seg * SEQ_P, hd, dir, seg, tid, wave, lane); }
                else { const int v = u - 48; scan_unit<0>(a, lds, (v >> 4) * SEQ_P, (v >> 1) & 7, v & 1, 0, tid, wave, lane); }
            }
            if (do_attn && G == 256) { const int an0 = bx < 48 ? 5 : 1, a00 = bx < 48 ? 5 * bx : 240 + (bx - 48); for (int j = 0; j < an0; ++j) attn_unit(a, l, lds, a00 + j, tid, wave, lane); }
            __syncthreads();
            xcd_barrier(bar, wave == 0 && lane_id() == 0);
            if (do_scan) for (int u = bx; u < 112; u += G) {
                if (u < 48) { const int v = 208 + u; scan_unit<0>(a, lds, (v >> 4) * SEQ_P, (v >> 1) & 7, v & 1, 0, tid, wave, lane); }
                else { const int v = u - 48, seg = v >> 4; scan_unit<2>(a, lds, NSEQ_P * SEQ_P + seg * SEQ_P, (v >> 1) & 7, v & 1, seg, tid, wave, lane); }
            }
            { int a0 = bx, astr = G, an = (1280 - bx + G - 1) / G, aex = -1;
              if (G == 256) { astr = 1; if (bx < 112) { a0 = 448 + bx; an = 1; } else { a0 = 560 + 5 * (bx - 112); an = 5; } }
              if (do_attn) for (int j = 0; j < an + (aex >= 0 ? 1 : 0); ++j) attn_unit(a, l, lds, j < an ? a0 + j * astr : aex, tid, wave, lane);
              if (do_fin && G == 256 && bx >= 112) finalize_a(a, l, (bx - 112) * NWAVES + wave, 144 * NWAVES, lane, 0, FIN_EARLY); }
            __syncthreads();
            SEAM(pb + 2);
        }
        if (sub != 0 && PHON(3) && IN(pb + 3)) { LOCALS(); finalize_a(a, l, gw, ngw, lane, G == 256 ? FIN_EARLY : 0, MTOK); SEAM(pb + 3); }
        if (sub != 0 && PHON(4) && IN(pb + 4)) { LOCALS();
            pg8::Gemm g{(const bf16*)(a.ws + WS_AOUT), (const bf16*)(a.ws + WS_BOUT), (const bf16*)(wsw + W_A), MTOK, DM, DM, HW}; pg8::StaticOrder S; S.init(MTOK, DM, G, bx);
            EpiMergeF E{(const bf16*)(a.ws + P_GA), (const bf16*)(a.ws + P_GBB), (bf16*)(a.ws + WS_MERGED)};
            pg8::gemm_phase<EpiMergeF, pg8::StaticOrder>(lds, g, S, E, wave);
            SEAM(pb + 4);
        }
        if (sub != 0 && PHON(5) && IN(pb + 5)) { LOCALS();
            pg8::Gemm g{(const bf16*)(a.ws + WS_MERGED), nullptr, (const bf16*)(wsw + W_OUT), MTOK, DM, DM, DM}; pg8::StaticOrder S; S.init(MTOK, DM, G, bx);
            const float* gi = l == 0 ? a.ln_in_g : a.ln2_g + (size_t)(l - 1) * DM; const float* bi = l == 0 ? a.ln_in_b : a.ln2_b + (size_t)(l - 1) * DM;
            if (l == 0) { EpiResid<0> E{a.xp, a.xs, nullptr, stats_in, gi, bi, (unsigned short*)(a.ws + P_GA), (bf16*)(a.ws + P_GBB), nullptr, stats_1};
                pg8::gemm_phase<EpiResid<0>, pg8::StaticOrder>(lds, g, S, E, wave); }
            else { EpiResid<1> E{nullptr, nullptr, (const unsigned short*)a.out, stats_in, gi, bi, (unsigned short*)(a.ws + P_GA), (bf16*)(a.ws + P_GBB), nullptr, stats_1};
                pg8::gemm_phase<EpiResid<1>, pg8::StaticOrder>(lds, g, S, E, wave); }
            SEAM(pb + 5);
        }
        if (sub != 0 && PHON(6) && IN(pb + 6)) { LOCALS();
            pg8::Gemm g{(const bf16*)(a.ws + P_GBB), nullptr, (const bf16*)(wsw + W_FIN), MTOK, NFFN, DM, DM}; pg8::StaticOrder S; S.init(MTOK, NFFN, G, bx);
            EpiSwiglu E{stats_1, cv + 2 * NPROJ, cv + 2 * NPROJ + NFFN, (bf16*)(a.ws + WS_HID)};
            pg8::gemm_phase<EpiSwiglu, pg8::StaticOrder>(lds, g, S, E, wave);
            SEAM(pb + 6);
        }
        if (sub != 0 && PHON(7) && IN(pb + 7)) { LOCALS();
            pg8::Gemm g{(const bf16*)(a.ws + WS_HID), nullptr, (const bf16*)(wsw + W_FOUT), MTOK, DM, DFF, DFF}; pg8::StaticOrder S; S.init(MTOK, DM, G, bx);
            EpiResid<1> E{nullptr, nullptr, (const unsigned short*)(a.ws + P_GA), stats_1, a.ln1_g + (size_t)l * DM, a.ln1_b + (size_t)l * DM,
                          l == DEPTH - 1 ? nullptr : (unsigned short*)a.out, l == DEPTH - 1 ? nullptr : ybf, l == DEPTH - 1 ? a.out : nullptr, stats_2};
            pg8::gemm_phase<EpiResid<1>, pg8::StaticOrder>(lds, g, S, E, wave);
            SEAM(pb + 7);
        }
    }
    if (PHON(9) && IN(N_PHASES - 1)) { LAUNDER(); final_ln(a, gw, ngw, lane); }
#undef IN
#undef SEAM
#undef LAUNDER
#undef LOCALS
}

extern "C" void kernel_launch(void* const* d_in, const int* in_sizes, int n_in, void* d_out, int out_size, void* d_ws, size_t ws_size, hipStream_t stream) {
    static int grid = 0;
    if (grid == 0) {
        if (n_in != 17 || out_size != MTOK * DM || ws_size < WS_END) { fprintf(stderr, "kernel_launch: unexpected shapes (n_in %d out %d ws %zu need %zu)\n", n_in, out_size, ws_size, (size_t)WS_END); grid = -1; return; }
        int dev = 0, cus = 0, per_cu = 0;
        if (hipGetDevice(&dev) != hipSuccess || hipDeviceGetAttribute(&cus, hipDeviceAttributeMultiprocessorCount, dev) != hipSuccess) { grid = -1; return; }
        if (hipFuncSetAttribute((const void*)enc_fwd, hipFuncAttributeMaxDynamicSharedMemorySize, LDS_BYTES) != hipSuccess) { fprintf(stderr, "kernel_launch: hipFuncSetAttribute failed\n"); grid = -1; return; }
        if (hipOccupancyMaxActiveBlocksPerMultiprocessor(&per_cu, (const void*)enc_fwd, NTHREADS, LDS_BYTES) != hipSuccess || per_cu < 1) { fprintf(stderr, "kernel_launch: occupancy query says %d\n", per_cu); }
        (void)hipGetLastError();
        grid = cus;
    }
    if (grid < 0) return;
    (void)hipMemsetAsync((char*)d_ws, 0, ZERO_BYTES, stream);
    Args a{};
    a.xp = (const float*)d_in[0]; a.xs = (const float*)d_in[1]; a.ln_in_g = (const float*)d_in[2]; a.ln_in_b = (const float*)d_in[3]; a.w_in = (const float*)d_in[4];
    a.lb_logits = (const float*)d_in[5]; a.hg_norm_g = (const float*)d_in[6]; a.attn_sink = (const float*)d_in[7]; a.w_a = (const float*)d_in[8]; a.w_b = (const float*)d_in[9];
    a.w_out = (const float*)d_in[10]; a.ln1_g = (const float*)d_in[11]; a.ln1_b = (const float*)d_in[12]; a.w_ffn_in = (const float*)d_in[13]; a.w_ffn_out = (const float*)d_in[14];
    a.ln2_g = (const float*)d_in[15]; a.ln2_b = (const float*)d_in[16]; a.out = (float*)d_out; a.ws = (unsigned char*)d_ws;
#if MK_PER_PHASE_LAUNCH
    for (int p = 0; p < N_PHASES; ++p) { a.ph_lo = p; a.ph_hi = p + 1; hipLaunchKernelGGL(enc_fwd, dim3(grid), dim3(NTHREADS), LDS_BYTES, stream, a); }
#else
    a.ph_lo = 0; a.ph_hi = N_PHASES;
    hipLaunchKernelGGL(enc_fwd, dim3(grid), dim3(NTHREADS), LDS_BYTES, stream, a);
#endif
}
```

```cpp
#include <hip/hip_runtime.h>
#include <cstdio>
#include <cstdint>

#ifndef MK_PER_PHASE_LAUNCH
#define MK_PER_PHASE_LAUNCH 0
#endif

namespace pg8 {
#define PG8_LAS __attribute__((address_space(3)))
typedef unsigned short bf16_t;
typedef short bf16x8 __attribute__((ext_vector_type(8)));
typedef _Float16 f16x8 __attribute__((ext_vector_type(8)));
typedef float f32x4 __attribute__((ext_vector_type(4)));
typedef unsigned u32x4 __attribute__((ext_vector_type(4)));
typedef unsigned u32x2 __attribute__((ext_vector_type(2)));
constexpr int BM = 256, BK = 64, HALF = 128, HTB = HALF * BK * 2, STAGE_BYTES = 8 * HTB, NXCD = 8, WGM = 4;

__host__ __device__ __forceinline__ int lds_byte(int r, int c) { const int st = (r >> 4) * 2 + (c >> 5), rr = r & 15, cc = c & 31, ob = rr * 64 + cc * 2; return st * 1024 + (ob ^ (((ob >> 9) & 1) << 5)); }
__host__ __device__ __forceinline__ void stage_rc(int b, int& R, int& C) { const int st = b / 1024, sb = b % 1024, swz = sb ^ (((sb >> 9) & 1) << 5); R = (st >> 1) * 16 + swz / 64; C = (st & 1) * 32 + (swz % 64) / 2; }
__host__ __device__ __forceinline__ int perm32(int rho) { const int n = rho >> 4, i = rho & 15; return 8 * (i >> 2) + 4 * n + (i & 3); }

struct Unit { int pm, pn; };
struct Gemm { const bf16_t* A; const bf16_t* A2; const bf16_t* Bt; int M, N, K, lda; };

struct StaticOrder {
    int nM, nN, nwg, G, c;
    __host__ __device__ void init(int M, int N, int G_, int c_) { nM = M / BM; nN = N / BM; nwg = nM * nN; G = G_; c = c_; }
    __host__ __device__ bool next(int i, Unit& u) const {
        const long L = (long)i * G + c; if (L >= nwg) return false;
        int wgid = (int)L; { const int q = nwg / NXCD, r = nwg % NXCD, xcd = wgid % NXCD, off = wgid / NXCD; wgid = (xcd < r ? xcd * (q + 1) : r * (q + 1) + (xcd - r) * q) + off; }
        const int nig = WGM * nN, gid = wgid / nig, fm = gid * WGM, gsz = (nM - fm) < WGM ? (nM - fm) : WGM;
        u.pm = fm + ((wgid % nig) % gsz); u.pn = (wgid % nig) / gsz; return true;
    }
    __device__ __forceinline__ void a_ready(const Unit&) const {}
    __device__ __forceinline__ void done(const Unit&) const {}
};

__device__ __forceinline__ unsigned cvt_pk_bf16(float lo, float hi) { unsigned r; asm volatile("v_cvt_pk_bf16_f32 %0, %1, %2" : "=v"(r) : "v"(lo), "v"(hi)); return r; }
__device__ __forceinline__ unsigned cvt_pk_f16(float lo, float hi) { unsigned r; asm volatile("v_cvt_pk_f16_f32 %0, %1, %2" : "=v"(r) : "v"(lo), "v"(hi)); return r; }

#ifndef GP_ALIGN
#define GP_ALIGN true
#endif
#ifndef GP_SP2
#define GP_SP2 true
#endif
template <class Epi, class Sched, bool ALIGN_EPI = GP_ALIGN, bool SP2 = GP_SP2>
__device__ __forceinline__ void gemm_phase(PG8_LAS unsigned char* lds, const Gemm g_, const Sched& S, const Epi& E, int wid_) {
    int tid_; asm volatile("v_mbcnt_lo_u32_b32 %0, -1, 0\n\tv_mbcnt_hi_u32_b32 %0, -1, %0" : "=v"(tid_)); tid_ += wid_ * 64;
    Gemm g = g_; asm volatile("" : "+s"(g.A), "+s"(g.A2), "+s"(g.Bt));
    const int tid = tid_, wid = __builtin_amdgcn_readfirstlane(tid >> 6), lane = tid & 63, wr = wid >> 2, wc = wid & 3, fr = lane & 15, fq = lane >> 4;
    const int K = g.K, nt = K / BK;
    unsigned voffA[2], voffB[2];
#define PG8_VOFF(tidv) do { _Pragma("unroll") for (int i = 0; i < 2; ++i) { int R, C; stage_rc((tidv) * 16 + i * 8192, R, C); const int Rb = Epi::PERM ? ((R & ~31) + perm32(R & 31)) : R; \
        voffA[i] = (unsigned)(R * g.lda + C) * 2u; voffB[i] = (unsigned)(Rb * K + C) * 2u; } } while (0)
    PG8_VOFF(tid);
    constexpr unsigned kstep = BK * 2;
    const unsigned hstep = (unsigned)(HALF * K * 2), hstepA = (unsigned)(HALF * g.lda * 2);
    const unsigned tstep = 2 * hstep, tstepA = 2 * hstepA;
    const bool dualA = g.A2 != nullptr; const int ntA = dualA ? nt / 2 : nt; const int a2delta = dualA ? (int)(((const char*)g.A2 - (const char*)g.A) - (ptrdiff_t)ntA * (ptrdiff_t)kstep) : 0;
    const unsigned ldsw = (unsigned)wid * 1024u;
    const int aoff = lds_byte(wr * 64 + fr, fq * 8), boff = lds_byte(wc * 32 + fr, fq * 8);
#define PG8_SA(b, h) (((b) * 2 + (h)) * HTB)
#define PG8_SB(b, h) ((4 + (b) * 2 + (h)) * HTB)
#define PG8_STAGE(bufoff, gbase, voff) do { _Pragma("unroll") for (int _i = 0; _i < 2; ++_i) \
        __builtin_amdgcn_global_load_lds((const unsigned*)((const char*)(gbase) + (voff)[_i]), (PG8_LAS unsigned*)(lds + (bufoff) + ldsw + _i * 8192), 16, 0, 0); } while (0)
#define PG8_LDA(dst, b, h) do { _Pragma("unroll") for (int m = 0; m < 4; ++m) _Pragma("unroll") for (int k = 0; k < 2; ++k) dst[m][k] = *(const PG8_LAS bf16x8*)(lds + PG8_SA(b, h) + aoff + m * 2048 + k * 1024); } while (0)
#define PG8_LDB(dst, b, h) do { _Pragma("unroll") for (int n = 0; n < 2; ++n) _Pragma("unroll") for (int k = 0; k < 2; ++k) dst[n][k] = *(const PG8_LAS bf16x8*)(lds + PG8_SB(b, h) + boff + n * 2048 + k * 1024); } while (0)
#define PG8_MMA(ai, bj, At, Bt) do { __builtin_amdgcn_s_setprio(1); _Pragma("unroll") for (int m = 0; m < 4; ++m) _Pragma("unroll") for (int n = 0; n < 2; ++n) _Pragma("unroll") for (int k = 0; k < 2; ++k) { \
        if constexpr (Epi::F16) acc[ai][bj][m][n] = __builtin_amdgcn_mfma_f32_16x16x32_f16(__builtin_bit_cast(f16x8, Bt[n][k]), __builtin_bit_cast(f16x8, At[m][k]), acc[ai][bj][m][n], 0, 0, 0); \
        else acc[ai][bj][m][n] = __builtin_amdgcn_mfma_f32_16x16x32_bf16(Bt[n][k], At[m][k], acc[ai][bj][m][n], 0, 0, 0); } __builtin_amdgcn_s_setprio(0); } while (0)
#define PG8_WAIT_V(n) asm volatile("s_waitcnt vmcnt(" #n ")" ::: "memory")
#define PG8_WAIT_L(n) asm volatile("s_waitcnt lgkmcnt(" #n ")" ::: "memory")
#define PG8_BAR __builtin_amdgcn_s_barrier()
#define PG8_SCHED __builtin_amdgcn_sched_barrier(0)
    Unit cur, nxt; int ui = 0;
    if (!S.next(0, cur)) return;
    f32x4 acc[2][2][4][2];
#pragma unroll
    for (int a = 0; a < 2; ++a)
#pragma unroll
        for (int b = 0; b < 2; ++b)
#pragma unroll
            for (int m = 0; m < 4; ++m)
#pragma unroll
                for (int n = 0; n < 2; ++n) acc[a][b][m][n] = (f32x4){0.f, 0.f, 0.f, 0.f};
    bf16x8 At[4][2], B0[2][2], B1[2][2];
    const char* cA = (const char*)g.A + (size_t)cur.pm * tstepA; const char* cB = (const char*)g.Bt + (size_t)cur.pn * tstep;
    S.a_ready(cur);
    if constexpr (SP2) {
        PG8_STAGE(PG8_SB(0, 0), cB, voffB); PG8_STAGE(PG8_SB(0, 1), cB + hstep, voffB); PG8_STAGE(PG8_SA(0, 0), cA, voffA); PG8_STAGE(PG8_SA(0, 1), cA + hstepA, voffA);
        if (wr == 1) PG8_BAR;
        PG8_WAIT_V(2); PG8_BAR;
        PG8_STAGE(PG8_SB(1, 0), cB + kstep, voffB); PG8_STAGE(PG8_SA(1, 0), cA + kstep, voffA); PG8_STAGE(PG8_SB(1, 1), cB + hstep + kstep, voffB);
        PG8_WAIT_V(6); PG8_BAR;
    } else {
        PG8_STAGE(PG8_SB(0, 0), cB, voffB); PG8_STAGE(PG8_SA(0, 0), cA, voffA); PG8_STAGE(PG8_SB(0, 1), cB + hstep, voffB); PG8_STAGE(PG8_SA(0, 1), cA + hstepA, voffA);
        if (wr == 1) PG8_BAR;
        PG8_WAIT_V(4); PG8_BAR;
        PG8_STAGE(PG8_SB(1, 0), cB + kstep, voffB); PG8_STAGE(PG8_SA(1, 0), cA + kstep, voffA); PG8_STAGE(PG8_SB(1, 1), cB + hstep + kstep, voffB);
        PG8_WAIT_V(6); PG8_BAR;
    }
    for (;;) {
        const bool has_next = S.next(ui + 1, nxt);
        const char* nA = has_next ? (const char*)g.A + (size_t)nxt.pm * tstepA : cA; const char* nB = has_next ? (const char*)g.Bt + (size_t)nxt.pn * tstep : cB;
        for (int t = 0; t < nt; t += 2) {
            const bool last = (t == nt - 2);
            const char* a1 = cA + (ptrdiff_t)((t >= ntA ? a2delta : 0) + (int)((t + 1) * kstep));
            const char* a2 = last ? nA : cA + (ptrdiff_t)((t + 2 >= ntA ? a2delta : 0) + (int)((t + 2) * kstep)); const char* b2 = last ? nB : cB + (size_t)((t + 2) * kstep);
            const char* a3 = a2 + kstep; const char* b3 = b2 + kstep;
            if (last && has_next) S.a_ready(nxt);
            if constexpr (Epi::HAS_MID) { if (t == ntA) { int fr_ = fr, fq_ = fq; asm volatile("" : "+v"(fr_), "+v"(fq_)); E.mid(acc, cur, wr, wc, fr_, fq_); } }
            if constexpr (SP2) {
            PG8_LDB(B0, 0, 0); PG8_LDB(B1, 0, 1); PG8_SCHED; PG8_LDA(At, 0, 0); PG8_STAGE(PG8_SA(1, 1), a1 + hstepA, voffA);
            PG8_WAIT_V(8); PG8_WAIT_L(0); PG8_BAR; PG8_MMA(0, 0, At, B0); PG8_MMA(0, 1, At, B1); PG8_BAR; PG8_SCHED;
            PG8_LDA(At, 0, 1); PG8_STAGE(PG8_SB(0, 0), b2, voffB); PG8_STAGE(PG8_SB(0, 1), b2 + hstep, voffB); PG8_STAGE(PG8_SA(0, 0), a2, voffA);
            PG8_WAIT_V(8); PG8_WAIT_L(0); PG8_BAR; PG8_MMA(1, 0, At, B0); PG8_MMA(1, 1, At, B1); PG8_BAR; PG8_SCHED;
            PG8_LDB(B0, 1, 0); PG8_LDB(B1, 1, 1); PG8_SCHED; PG8_LDA(At, 1, 0); PG8_STAGE(PG8_SA(0, 1), a2 + hstepA, voffA);
            PG8_WAIT_V(8); PG8_WAIT_L(0); PG8_BAR; PG8_MMA(0, 0, At, B0); PG8_MMA(0, 1, At, B1); PG8_BAR; PG8_SCHED;
            PG8_LDA(At, 1, 1); PG8_STAGE(PG8_SB(1, 0), b3, voffB); PG8_STAGE(PG8_SB(1, 1), b3 + hstep, voffB); PG8_STAGE(PG8_SA(1, 0), a3, voffA);
            PG8_WAIT_V(8); PG8_WAIT_L(0); PG8_BAR; PG8_MMA(1, 0, At, B0); PG8_MMA(1, 1, At, B1); PG8_BAR; PG8_SCHED;
            } else {
            PG8_LDB(B0, 0, 0); PG8_SCHED; PG8_LDA(At, 0, 0); PG8_STAGE(PG8_SA(1, 1), a1 + hstepA, voffA);
            PG8_WAIT_L(8); PG8_BAR; PG8_WAIT_L(0); PG8_MMA(0, 0, At, B0); PG8_BAR; PG8_SCHED;
            PG8_LDB(B1, 0, 1); PG8_STAGE(PG8_SB(0, 0), b2, voffB);
            PG8_BAR; PG8_WAIT_L(0); PG8_MMA(0, 1, At, B1); PG8_BAR;
            PG8_LDA(At, 0, 1); PG8_STAGE(PG8_SA(0, 0), a2, voffA);
            PG8_BAR; PG8_WAIT_L(0); PG8_MMA(1, 0, At, B0); PG8_BAR; PG8_SCHED;
            PG8_STAGE(PG8_SB(0, 1), b2 + hstep, voffB);
            PG8_WAIT_V(6); PG8_BAR; PG8_MMA(1, 1, At, B1); PG8_BAR;
            PG8_LDB(B0, 1, 0); PG8_SCHED; PG8_LDA(At, 1, 0); PG8_STAGE(PG8_SA(0, 1), a2 + hstepA, voffA);
            PG8_WAIT_L(8); PG8_BAR; PG8_WAIT_L(0); PG8_MMA(0, 0, At, B0); PG8_BAR; PG8_SCHED;
            PG8_LDB(B1, 1, 1); PG8_STAGE(PG8_SB(1, 0), b3, voffB);
            PG8_BAR; PG8_WAIT_L(0); PG8_MMA(0, 1, At, B1); PG8_BAR;
            PG8_LDA(At, 1, 1); PG8_STAGE(PG8_SA(1, 0), a3, voffA);
            PG8_BAR; PG8_WAIT_L(0); PG8_MMA(1, 0, At, B0); PG8_BAR; PG8_SCHED;
            PG8_STAGE(PG8_SB(1, 1), b3 + hstep, voffB);
            PG8_WAIT_V(6); PG8_BAR; PG8_MMA(1, 1, At, B1); PG8_BAR;
            }
        }
        if constexpr (ALIGN_EPI) { if (wr == 0) PG8_BAR; }
        { int fr_ = fr, fq_ = fq; asm volatile("" : "+v"(fr_), "+v"(fq_));
          E(acc, cur, wr, wc, fr_, fq_); }
        if (!has_next) break;
        { int tid2; asm volatile("v_mbcnt_lo_u32_b32 %0, -1, 0\n\tv_mbcnt_hi_u32_b32 %0, -1, %0" : "=v"(tid2)); tid2 += wid_ * 64; PG8_VOFF(tid2); }
#pragma unroll
        for (int a = 0; a < 2; ++a)
#pragma unroll
            for (int b = 0; b < 2; ++b)
#pragma unroll
                for (int m = 0; m < 4; ++m)
#pragma unroll
                    for (int n = 0; n < 2; ++n) acc[a][b][m][n] = (f32x4){0.f, 0.f, 0.f, 0.f};
        cur = nxt; cA = nA; cB = nB; ++ui;
        if constexpr (ALIGN_EPI) { if (wr == 1) PG8_BAR; }
    }
    PG8_WAIT_V(0);
    if constexpr (!ALIGN_EPI) { if (wr == 0) PG8_BAR; }
    PG8_BAR;
#undef PG8_VOFF
#undef PG8_SA
#undef PG8_SB
#undef PG8_STAGE
#undef PG8_LDA
#undef PG8_LDB
#undef PG8_MMA
#undef PG8_WAIT_V
#undef PG8_WAIT_L
#undef PG8_BAR
#undef PG8_SCHED
}
}

constexpr int NWAVES = 8, NTHREADS = NWAVES * 64;
constexpr int DM = 2048, DEPTH = 4, NPROJ = 10752, DFF = 5632, NFFN = 2 * DFF;
constexpr int SEQ_P = 2048, NSEQ_P = 16, SEQ_S = 8192;
constexpr int MTOK = NSEQ_P * SEQ_P + SEQ_S;
constexpr int HW = 1024;
constexpr int KVW = 256;
constexpr float LN_EPS = 1e-5f, RMS_EPS = 1e-6f;
constexpr float ALPHA = 1.6817928305074292f;
constexpr float LOG2E = 1.4426950408889634f;
constexpr float QSCALE = 0.08838834764831845f * 1.4426950408889634f;

constexpr size_t MiB = 1u << 20;
constexpr size_t WS_CTL = 0;
constexpr size_t WS_STATS = 64 * 1024;
constexpr size_t STATS_BYTES = (size_t)MTOK * 8;
constexpr size_t WS_CVEC = WS_STATS + 9 * STATS_BYTES;
constexpr size_t CVEC_LAYER = (size_t)(2 * NPROJ + 2 * NFFN) * 4;
constexpr size_t ZERO_BYTES = 4 * MiB;
static_assert(WS_CVEC + DEPTH * CVEC_LAYER <= ZERO_BYTES, "zeroed region");
constexpr size_t WS_LB = 4 * MiB;
constexpr size_t WS_COS = 5 * MiB, WS_SIN = 7 * MiB;
constexpr size_t WS_SEGE = 9 * MiB;
constexpr size_t WS_SEGD = 13 * MiB;
constexpr size_t WS_W = 14 * MiB;
constexpr size_t W_IN = 0, W_A = W_IN + (size_t)NPROJ * DM * 2, W_B = W_A + (size_t)DM * HW * 2, W_OUT = W_B + (size_t)DM * HW * 2,
                 W_FIN = W_OUT + (size_t)DM * DM * 2, W_FOUT = W_FIN + (size_t)NFFN * DM * 2, W_END = W_FOUT + (size_t)DM * DFF * 2;
static_assert(W_END == 124 * MiB, "weights per layer");
constexpr size_t WS_YBF = WS_W + 124 * MiB;
static_assert(WS_SEGE + 64 * 512 * 32 * 4 <= WS_SEGD && WS_SEGD + 64 * 128 * 4 <= WS_W, "segment state buffers");
constexpr size_t WS_PROJ = WS_YBF + 160 * MiB;
constexpr size_t SZ1K = (size_t)MTOK * HW * 2;
constexpr size_t P_HQ = WS_PROJ, P_GF = P_HQ + SZ1K, P_GB = P_GF + SZ1K, P_HI = P_GB + SZ1K, P_HG = P_HI + SZ1K, P_AQ = P_HG + SZ1K,
                 P_AK = P_AQ + SZ1K, P_AV = P_AK + SZ1K / 4, P_GA = P_AV + SZ1K / 4, P_GBB = P_GA + 2 * SZ1K, P_END = P_GBB + 2 * SZ1K;
constexpr size_t WS_MERGED = P_HQ;
constexpr size_t WS_HID = P_HQ;
static_assert((size_t)MTOK * DFF * 2 <= P_END - P_HQ, "hidden overlay");
constexpr size_t WS_AOUT = P_END, WS_BOUT = WS_AOUT + SZ1K, WS_OBWD = WS_BOUT + SZ1K, WS_END = WS_OBWD + SZ1K;
static_assert(WS_END <= 1408 * MiB, "workspace");

constexpr int RING_BYTES = 131072;
constexpr int MISC_OFF = RING_BYTES;
constexpr int LDS_BYTES = 147456;

#define GAS __attribute__((address_space(1)))
#define LAS __attribute__((address_space(3)))
typedef unsigned short bf16;
typedef float f32x4 __attribute__((ext_vector_type(4)));
typedef float f32x16 __attribute__((ext_vector_type(16)));
typedef short bf16x8 __attribute__((ext_vector_type(8)));
typedef short s16x4 __attribute__((ext_vector_type(4)));
typedef unsigned u32x4 __attribute__((ext_vector_type(4)));
typedef unsigned u32x2 __attribute__((ext_vector_type(2)));
typedef float f32x2 __attribute__((ext_vector_type(2)));
typedef int i32x2 __attribute__((ext_vector_type(2)));
constexpr float STAT_Q1 = 8192.f, STAT_S1 = 1.0f / 8192.f, STAT_Q2 = 512.f, STAT_S2 = 1.0f / 512.f;

__device__ __forceinline__ float bf2f(unsigned short b) { return __uint_as_float(((unsigned)b) << 16); }
__device__ __forceinline__ unsigned f2bf(float f) { unsigned u = __float_as_uint(f); return (u + 0x7fffu + ((u >> 16) & 1u)) >> 16; }
__device__ __forceinline__ unsigned pk2(float lo, float hi) { return pg8::cvt_pk_bf16(lo, hi); }
__device__ __forceinline__ unsigned pk2h(float lo, float hi) { return pg8::cvt_pk_f16(lo, hi); }
typedef _Float16 f16x2 __attribute__((ext_vector_type(2)));
__device__ __forceinline__ float h2f_lo(unsigned u) { return (float)__builtin_bit_cast(f16x2, u)[0]; }
__device__ __forceinline__ float h2f_hi(unsigned u) { return (float)__builtin_bit_cast(f16x2, u)[1]; }
__device__ __forceinline__ float fexp2(float x) { return __builtin_amdgcn_exp2f(x); }
__device__ __forceinline__ float frcp(float x) { return __builtin_amdgcn_rcpf(x); }
template <int FRAC> __device__ __forceinline__ float qfix(float v) { return __builtin_rintf(v * (float)(1 << FRAC)) * (1.0f / (float)(1 << FRAC)); }
__device__ __forceinline__ float sigmoidf_(float x) { return frcp(1.0f + fexp2(-x * LOG2E)); }
__device__ __forceinline__ float siluf_(float x) { return x * sigmoidf_(x); }

__device__ __forceinline__ int lane_id() { int l; asm volatile("v_mbcnt_lo_u32_b32 %0, -1, 0\n\tv_mbcnt_hi_u32_b32 %0, -1, %0" : "=v"(l)); return l; }

#define XB_TMO      128
#define XB_XCNT(j)  (256  + 64 * (j))
#define XB_XSUB(j)  (1280 + 64 * (j))
#define XB_XGEN(j)  (2304 + 64 * (j))
#define XB_TOP      3328
#define XB_TOPGEN   3392
#define XCD_BAR_WORDS 3456
#define XB_SPIN_CAP (1u << 24)
__device__ __forceinline__ unsigned xb_ld(unsigned* p)              { return __hip_atomic_load(p, __ATOMIC_RELAXED, __HIP_MEMORY_SCOPE_AGENT); }
__device__ __forceinline__ unsigned xb_add(unsigned* p, unsigned v) { return __hip_atomic_fetch_add(p, v, __ATOMIC_RELAXED, __HIP_MEMORY_SCOPE_AGENT); }
__device__ __forceinline__ unsigned xb_xcc_id() { return (unsigned)__builtin_amdgcn_s_getreg((3 << 11) | 20) & 0xFu; }
#define XB_SPIN(cond, bar) do { unsigned _sp = 0; while (cond) { __builtin_amdgcn_s_sleep(1); \
    if ((++_sp & 255u) == 0u) { if (xb_ld(&(bar)[XB_TMO])) break; if (_sp > XB_SPIN_CAP) { atomicAdd(&(bar)[XB_TMO], 1u); break; } } } } while (0)
struct XcdBarrier { unsigned* bar; unsigned x; volatile LAS unsigned* st; };
__device__ __forceinline__ XcdBarrier xcd_barrier_post(unsigned* bar, volatile LAS unsigned* st, bool leader) {
    XcdBarrier b; b.bar = bar; b.x = xb_xcc_id(); b.st = st;
    if (leader) (void)xb_add(&bar[XB_XCNT(b.x)], 1u);
    return b;
}
__device__ __forceinline__ void xcd_barrier_complete(unsigned* bar, unsigned x, unsigned& nloc, unsigned& nx) {
    const unsigned G = gridDim.x * gridDim.y * gridDim.z;
    unsigned sum, cnt, mine, sp = 0u;
    for (;;) {
        sum = 0u; cnt = 0u; mine = 0u;
#pragma unroll
        for (unsigned j = 0; j < 16; ++j) { const unsigned c = xb_ld(&bar[XB_XCNT(j)]); sum += c; cnt += (c > 0u) ? 1u : 0u; mine = (j == x) ? c : mine; }
        if (sum == G) break;
        __builtin_amdgcn_s_sleep(1);
        if ((++sp & 255u) == 0u) { if (xb_ld(&bar[XB_TMO])) break; if (sp > XB_SPIN_CAP) { atomicAdd(&bar[XB_TMO], 1u); break; } }
    }
    nloc = mine > 0u ? mine : 1u; nx = cnt > 0u ? cnt : 1u;
}
__device__ __forceinline__ void xcd_barrier(const XcdBarrier& b, bool leader) {
    asm volatile("s_waitcnt vmcnt(0)" ::: "memory");
    __syncthreads();
    if (leader) {
        unsigned* bar = b.bar;
        __builtin_amdgcn_s_waitcnt(0);
        unsigned nloc = b.st[0], nx = b.st[1];
        if (nloc == 0u) { xcd_barrier_complete(bar, b.x, nloc, nx); b.st[0] = nloc; b.st[1] = nx; }
        const unsigned old = xb_add(&bar[XB_XSUB(b.x)], 1u);
        const unsigned gen = old / nloc;
        if (old + 1u == (gen + 1u) * nloc) {
            __builtin_amdgcn_fence(__ATOMIC_RELEASE, "agent");
            asm volatile("s_waitcnt vmcnt(0)" ::: "memory");
            const unsigned og = xb_add(&bar[XB_TOP], 1u);
            const unsigned tg = og / nx;
            if (og + 1u == (tg + 1u) * nx) xb_add(&bar[XB_TOPGEN], 1u);
            else XB_SPIN(xb_ld(&bar[XB_TOPGEN]) == tg, bar);
            __builtin_amdgcn_fence(__ATOMIC_ACQUIRE, "agent");
            xb_add(&bar[XB_XGEN(b.x)], 1u);
            asm volatile("s_waitcnt vmcnt(0)" ::: "memory");
        } else {
            XB_SPIN(xb_ld(&bar[XB_XGEN(b.x)]) == gen, bar);
            __builtin_amdgcn_fence(__ATOMIC_ACQUIRE, "agent");
            asm volatile("s_waitcnt vmcnt(0)" ::: "memory");
        }
    }
    __syncthreads();
}

struct Args {
    const float* xp; const float* xs; const float* ln_in_g; const float* ln_in_b; const float* w_in; const float* lb_logits; const float* hg_norm_g; const float* attn_sink;
    const float* w_a; const float* w_b; const float* w_out; const float* ln1_g; const float* ln1_b; const float* w_ffn_in; const float* w_ffn_out; const float* ln2_g; const float* ln2_b;
    float* out; unsigned char* ws; int ph_lo, ph_hi;
};

__device__ __forceinline__ float wave_sum(float v) {
#pragma unroll
    for (int o = 1; o < 64; o <<= 1) v += __shfl_xor(v, o);
    return v;
}

__device__ __forceinline__ void row_norm(const float* st, int row, float& A, float& B) {
    const int2 si = *(const int2*)(st + 2 * (size_t)row); float2 s; s.x = (float)si.x * STAT_S1; s.y = (float)si.y * STAT_S2;
    const float mean = s.x * (1.0f / DM); const float var = fmaxf(s.y * (1.0f / DM) - mean * mean, 0.f);
    const float rstd = 1.0f / sqrtf(var + LN_EPS); A = rstd; B = -mean * rstd;
}

template <int MAPKIND>
__device__ __forceinline__ int colmap(int n) {
    if (MAPKIND == 1) { if (n >= 6656) { const int t = (n - 6656) >> 8, i = (n - 6656) & 255; return (i < 128) ? (6656 + 128 * t + i) : (8704 + 128 * t + (i - 128)); }
        if (n >= 5120 && n < 6400) { const int hb = n & ~127, p = n & 127, j8 = p >> 3, e = p & 7; return hb + ((e < 4) ? (4 * j8 + e) : (64 + 4 * j8 + (e - 4))); } return n; }
    if (MAPKIND == 2) { const int t = n >> 8, i = n & 255; return (i < 128) ? (128 * t + i) : (DFF + 128 * t + (i - 128)); }
    return n;
}
template <int MAPKIND, bool FOLD>
__device__ __forceinline__ void transpose_item(const float* W, int K, int N, bf16* WT, int ldk, const float* gain, const float* bias, float* c1, float* c2, LAS float* scr, int item, int lane) {
    const int nblk = N / 32, kb = item / nblk, nb = item % nblk, k0 = 64 * kb, n0 = 32 * nb;
    const int ncol = colmap<MAPKIND>(n0 + (lane & 31));
    float s1 = 0.f, s2 = 0.f;
#pragma unroll 8
    for (int i = 0; i < 32; ++i) { const int kk = 2 * i + (lane >> 5); float w = W[(size_t)(k0 + kk) * N + ncol];
        if (FOLD) { const float gk = gain[k0 + kk], bk = bias[k0 + kk]; s2 += bk * w; w *= gk; s1 += __uint_as_float(f2bf(w) << 16); }
        scr[kk * 33 + (lane & 31)] = w; }
    if (FOLD) { s1 += __shfl_xor(s1, 32); s2 += __shfl_xor(s2, 32); if (lane < 32) { atomicAdd(c1 + n0 + lane, qfix<19>(s1)); atomicAdd(c2 + n0 + lane, qfix<21>(s2)); } }
    asm volatile("s_waitcnt lgkmcnt(0)" ::: "memory");
    const int c = lane & 7;
#pragma unroll
    for (int j = 0; j < 4; ++j) { const int n = (lane >> 3) + 8 * j; const LAS float* s = scr + (8 * c) * 33 + n;
        u32x4 o; o.x = pk2(s[0 * 33], s[1 * 33]); o.y = pk2(s[2 * 33], s[3 * 33]); o.z = pk2(s[4 * 33], s[5 * 33]); o.w = pk2(s[6 * 33], s[7 * 33]);
        *(u32x4*)(WT + (size_t)(n0 + n) * ldk + k0 + 8 * c) = o; }
    asm volatile("s_waitcnt lgkmcnt(0)" ::: "memory");
}

__device__ __forceinline__ void convert_layer(const Args& a, int l, LAS unsigned char* lds, int gw, int ngw, int wave, int lane) {
    LAS float* scr = (LAS float*)(lds + wave * 16384);
    unsigned char* wsw = a.ws + WS_W;
    float* cv = (float*)(a.ws + WS_CVEC + (size_t)l * CVEC_LAYER);
    const float* g_in = l == 0 ? a.ln_in_g : a.ln2_g + (size_t)(l - 1) * DM;
    const float* b_in = l == 0 ? a.ln_in_b : a.ln2_b + (size_t)(l - 1) * DM;
    constexpr int I_IN = (DM / 64) * (NPROJ / 32), I_A = (HW / 64) * (DM / 32), I_OUT = (DM / 64) * (DM / 32), I_FIN = (DM / 64) * (NFFN / 32), I_FOUT = (DFF / 64) * (DM / 32);
    constexpr int NITEMS = I_IN + 2 * I_A + I_OUT + I_FIN + I_FOUT;
    for (int it = gw; it < NITEMS; it += ngw) {
        int r = it;
        if (r < I_IN) { transpose_item<1, true>(a.w_in + (size_t)l * DM * NPROJ, DM, NPROJ, (bf16*)(wsw + W_IN), DM, g_in, b_in, cv, cv + NPROJ, scr, r, lane); continue; } r -= I_IN;
        if (r < I_FIN) { transpose_item<2, true>(a.w_ffn_in + (size_t)l * DM * NFFN, DM, NFFN, (bf16*)(wsw + W_FIN), DM, a.ln1_g + (size_t)l * DM, a.ln1_b + (size_t)l * DM, cv + 2 * NPROJ, cv + 2 * NPROJ + NFFN, scr, r, lane); continue; } r -= I_FIN;
        if (r < I_FOUT) { transpose_item<0, false>(a.w_ffn_out + (size_t)l * DFF * DM, DFF, DM, (bf16*)(wsw + W_FOUT), DFF, nullptr, nullptr, nullptr, nullptr, scr, r, lane); continue; } r -= I_FOUT;
        if (r < I_OUT) { transpose_item<0, false>(a.w_out + (size_t)l * DM * DM, DM, DM, (bf16*)(wsw + W_OUT), DM, nullptr, nullptr, nullptr, nullptr, scr, r, lane); continue; } r -= I_OUT;
        if (r < I_A) { transpose_item<0, false>(a.w_a + (size_t)l * HW * DM, HW, DM, (bf16*)(wsw + W_A), DM, nullptr, nullptr, nullptr, nullptr, scr, r, lane); continue; } r -= I_A;
        transpose_item<0, false>(a.w_b + (size_t)l * HW * DM, HW, DM, (bf16*)(wsw + W_A) + HW, DM, nullptr, nullptr, nullptr, nullptr, scr, r, lane);
    }
}

__device__ __forceinline__ const float* xrow_ptr(const Args& a, int m) { return m < NSEQ_P * SEQ_P ? a.xp + (size_t)m * DM : a.xs + (size_t)(m - NSEQ_P * SEQ_P) * DM; }

__device__ __forceinline__ void prologue(const Args& a, int gw, int ngw, int lane) {
    { float* lb = (float*)(a.ws + WS_LB);
      for (int c = gw * 64 + lane; c < 2048; c += ngw * 64) {
          float v[DEPTH], mx = -1e30f, s = 0.f;
#pragma unroll
          for (int l = 0; l < DEPTH; ++l) { v[l] = a.lb_logits[l * 2048 + c]; mx = fmaxf(mx, v[l]); }
#pragma unroll
          for (int l = 0; l < DEPTH; ++l) { v[l] = expf(v[l] - mx); s += v[l]; }
          float cum = 0.f;
#pragma unroll
          for (int l = 0; l < DEPTH; ++l) { const float p = v[l] / s; cum += p; lb[l * 2048 + c] = cum - v[0] / s; }
      } }
    { float* ct = (float*)(a.ws + WS_COS); float* st = (float*)(a.ws + WS_SIN);
      for (int i = gw * 64 + lane; i < SEQ_S * 64; i += ngw * 64) { const int pos = i >> 6, j = i & 63;
          const double inv = pow(10000.0, -(double)(2 * j) / 128.0); const double ang = (double)pos * inv; ct[i] = (float)cos(ang); st[i] = (float)sin(ang); } }
    { float* st0 = (float*)(a.ws + WS_STATS); bf16* ybf = (bf16*)(a.ws + WS_YBF);
      for (int m = gw; m < MTOK; m += ngw) {
          const f32x4* xr = (const f32x4*)xrow_ptr(a, m) + lane; float s = 0.f, s2 = 0.f;
          unsigned long long* o8 = (unsigned long long*)(ybf + (size_t)m * DM) + lane;
#pragma unroll
          for (int j = 0; j < 8; ++j) { const f32x4 v = xr[64 * j]; s += (v.x + v.y) + (v.z + v.w); s2 += (v.x * v.x + v.y * v.y) + (v.z * v.z + v.w * v.w);
              o8[64 * j] = (unsigned long long)pk2(v.x, v.y) | ((unsigned long long)pk2(v.z, v.w) << 32); }
          s = wave_sum(s); s2 = wave_sum(s2);
          if (lane == 0) { ((int*)st0)[2 * (size_t)m] = (int)rintf(s * STAT_Q1); ((int*)st0)[2 * (size_t)m + 1] = (int)rintf(s2 * STAT_Q2); }
      } }
}

typedef pg8::f32x4 (&AccRef)[2][2][4][2];
template <class T> __device__ __forceinline__ T ldg(const void* base, unsigned off) { return *(const GAS T*)((const GAS char*)base + off); }
template <class T> __device__ __forceinline__ void stg(void* base, unsigned off, T v) { *(GAS T*)((GAS char*)base + off) = v; }
__device__ __forceinline__ void row_norm_o(const float* st, unsigned off8, float& A, float& B) {
    const i32x2 si = ldg<i32x2>(st, off8); f32x2 s; s.x = (float)si.x * STAT_S1; s.y = (float)si.y * STAT_S2;
    const float mean = s.x * (1.0f / DM); const float var = fmaxf(s.y * (1.0f / DM) - mean * mean, 0.f);
    const float rstd = 1.0f / sqrtf(var + LN_EPS); A = rstd; B = -mean * rstd;
}

__device__ __forceinline__ void load_row_norms(const float* st, int row0, float (&A)[8], float (&B)[8]) {
    i32x2 sv[8];
#pragma unroll
    for (int i = 0; i < 8; ++i) sv[i] = ldg<i32x2>(st, (unsigned)((row0 + (i >> 2) * 128 + (i & 3) * 16) * 8));
#pragma unroll
    for (int i = 0; i < 8; ++i) { const float mean = (float)sv[i].x * (STAT_S1 / DM); const float var = fmaxf((float)sv[i].y * (STAT_S2 / DM) - mean * mean, 0.f);
        const float rstd = 1.0f / sqrtf(var + LN_EPS); A[i] = rstd; B[i] = -mean * rstd; }
}

struct EpiProj {
    static constexpr bool PERM = true, HAS_MID = false, F16 = false;
    unsigned char* ws; const float* stats; const float* c1; const float* c2; const float* lb;
    __device__ __forceinline__ void operator()(AccRef acc, const pg8::Unit& u, int wr, int wc, int fr, int fq) const {
        const int pn = u.pn, row0 = u.pm * 256 + wr * 64 + fr, cl = wc * 32 + 8 * fq, colg = pn * 256 + cl;
        int type, ldc, dcol; size_t dbase;
        if (pn < 4)       { type = 0; dbase = P_HQ;  ldc = HW;  dcol = pn * 256; }
        else if (pn < 8)  { type = 1; dbase = P_GF;  ldc = HW;  dcol = (pn - 4) * 256; }
        else if (pn < 12) { type = 1; dbase = P_GB;  ldc = HW;  dcol = (pn - 8) * 256; }
        else if (pn < 16) { type = 2; dbase = P_HI;  ldc = HW;  dcol = (pn - 12) * 256; }
        else if (pn < 20) { type = 0; dbase = P_HG;  ldc = HW;  dcol = (pn - 16) * 256; }
        else if (pn < 24) { type = 3; dbase = P_AQ;  ldc = HW;  dcol = (pn - 20) * 256; }
        else if (pn < 25) { type = 4; dbase = P_AK;  ldc = KVW; dcol = 0; }
        else if (pn < 26) { type = 2; dbase = P_AV;  ldc = KVW; dcol = 0; }
        else              { type = 5; dbase = P_GA;  ldc = DM;  dcol = (pn - 26) * 128; }
        unsigned char* dst = ws + dbase;
        const unsigned doff0 = (unsigned)((row0 * ldc + dcol + cl) * 2), dstep = (unsigned)(16 * ldc * 2);
        const int pos0 = (u.pm < 128 ? ((u.pm & 7) * 256) : ((u.pm - 128) * 256)) + wr * 64 + fr;
        const unsigned roff0 = (unsigned)(pos0 * 256 + (16 * wc + 4 * fq) * 4);
        const float* cost = (const float*)(ws + WS_COS); const float* sint = (const float*)(ws + WS_SIN);
        float A[8], B[8]; load_row_norms(stats, row0, A, B);
        if (type == 5) {
            unsigned char* dstb = ws + P_GBB;
            pg8::f32x4 c1v[2][2], c2v[2][2];
#pragma unroll
            for (int bj = 0; bj < 2; ++bj)
#pragma unroll
                for (int n = 0; n < 2; ++n) { c1v[bj][n] = ldg<pg8::f32x4>(c1, (unsigned)((colg + bj * 128 + 4 * n) * 4)); c2v[bj][n] = ldg<pg8::f32x4>(c2, (unsigned)((colg + bj * 128 + 4 * n) * 4)) * (-LOG2E); }
            asm volatile("" ::: "memory");
#pragma unroll
            for (int ai = 0; ai < 2; ++ai)
#pragma unroll
                for (int m = 0; m < 4; ++m) {
                    const float Ar = -LOG2E * A[ai * 4 + m], Br = -LOG2E * B[ai * 4 + m];
                    float rt[8], gb[8];
#pragma unroll
                    for (int n = 0; n < 2; ++n)
#pragma unroll
                        for (int j = 0; j < 4; ++j) {
                            const float xa = __builtin_fmaf(acc[ai][0][m][n][j], Ar, __builtin_fmaf(c1v[0][n][j], Br, c2v[0][n][j])), xb = __builtin_fmaf(acc[ai][1][m][n][j], Ar, __builtin_fmaf(c1v[1][n][j], Br, c2v[1][n][j]));
                            const float ea = 1.0f + fexp2(fminf(xa, 80.f)), eb = 1.0f + fexp2(fminf(xb, 80.f)); gb[4 * n + j] = frcp(eb); rt[4 * n + j] = eb * frcp(ea); }
                    u32x4 wr_, wg_; wr_.x = pk2(rt[0], rt[1]); wr_.y = pk2(rt[2], rt[3]); wr_.z = pk2(rt[4], rt[5]); wr_.w = pk2(rt[6], rt[7]);
                    wg_.x = pk2(gb[0], gb[1]); wg_.y = pk2(gb[2], gb[3]); wg_.z = pk2(gb[4], gb[5]); wg_.w = pk2(gb[6], gb[7]);
                    const unsigned o = doff0 + (unsigned)(ai * 8 + m) * dstep;
                    stg<u32x4>(dst, o, wr_); stg<u32x4>(dstb, o, wg_);
                }
            return;
        }
#pragma unroll
        for (int bj = 0; bj < 2; ++bj) {
            pg8::f32x4 c1v[2], c2v[2], lbv[2];
#pragma unroll
            for (int n = 0; n < 2; ++n) { c1v[n] = ldg<pg8::f32x4>(c1, (unsigned)((colg + bj * 128 + 4 * n) * 4)); c2v[n] = ldg<pg8::f32x4>(c2, (unsigned)((colg + bj * 128 + 4 * n) * 4));
                lbv[n] = (type == 1) ? ldg<pg8::f32x4>(lb, (unsigned)(((pn - 4) * 256 + cl + bj * 128 + 4 * n) * 4)) : (pg8::f32x4){0.f, 0.f, 0.f, 0.f}; }
            asm volatile("" ::: "memory");
#pragma unroll
            for (int ai = 0; ai < 2; ++ai) {
                pg8::f32x4 cs[4], sn[4];
                if (type == 3 || type == 4) {
#pragma unroll
                    for (int m = 0; m < 4; ++m) { cs[m] = ldg<pg8::f32x4>(cost, roff0 + (unsigned)((ai * 128 + m * 16) * 256)); sn[m] = ldg<pg8::f32x4>(sint, roff0 + (unsigned)((ai * 128 + m * 16) * 256)); }
                    asm volatile("" ::: "memory");
                }
#pragma unroll
                for (int m = 0; m < 4; ++m) {
                    const float Ar = A[ai * 4 + m], Br = B[ai * 4 + m];
                    pg8::f32x4 v[2];
#pragma unroll
                    for (int n = 0; n < 2; ++n)
#pragma unroll
                        for (int j = 0; j < 4; ++j) v[n][j] = __builtin_fmaf(acc[ai][bj][m][n][j], Ar, __builtin_fmaf(c1v[n][j], Br, c2v[n][j]));
                    if (type == 0) {
#pragma unroll
                        for (int n = 0; n < 2; ++n)
#pragma unroll
                            for (int j = 0; j < 4; ++j) v[n][j] = v[n][j] * frcp(1.0f + fexp2(v[n][j] * -LOG2E));
                    } else if (type == 1) {
#pragma unroll
                        for (int n = 0; n < 2; ++n)
#pragma unroll
                            for (int j = 0; j < 4; ++j) { const float lbx = lbv[n][j]; const float f = __builtin_fmaf(1.0f - lbx, frcp(1.0f + fexp2(v[n][j] * -LOG2E)), lbx); v[n][j] = __builtin_amdgcn_logf(fmaxf(f, 1e-30f)); }
                    } else if (type == 3 || type == 4) {
                        const float sc = type == 3 ? QSCALE : 1.0f;
                        const pg8::f32x4 x1 = v[0], x2 = v[1]; v[0] = (x1 * cs[m] - x2 * sn[m]) * sc; v[1] = (x2 * cs[m] + x1 * sn[m]) * sc;
                    }
                    u32x4 w; w.x = pk2(v[0][0], v[0][1]); w.y = pk2(v[0][2], v[0][3]); w.z = pk2(v[1][0], v[1][1]); w.w = pk2(v[1][2], v[1][3]);
                    stg<u32x4>(dst, doff0 + (unsigned)(ai * 8 + m) * dstep + bj * 256, w);
                }
            }
        }
    }
};

struct EpiMergeF {
    static constexpr bool PERM = true, HAS_MID = true, F16 = false;
    const bf16* ratio; const bf16* gateb; bf16* merged;
    __device__ __forceinline__ void mid(AccRef acc, const pg8::Unit& u, int wr, int wc, int fr, int fq) const {
        const int row0 = u.pm * 256 + wr * 64 + fr, col0 = u.pn * 256 + wc * 32 + 8 * fq;
        const unsigned off0 = (unsigned)((row0 * DM + col0) * 2);
#pragma unroll
        for (int ai = 0; ai < 2; ++ai) {
            u32x4 gv[4][2];
#pragma unroll
            for (int m = 0; m < 4; ++m)
#pragma unroll
                for (int bj = 0; bj < 2; ++bj) gv[m][bj] = ldg<u32x4>(ratio, off0 + (unsigned)((ai * 128 + m * 16) * DM * 2) + bj * 256);
            asm volatile("" ::: "memory");
#pragma unroll
            for (int m = 0; m < 4; ++m)
#pragma unroll
                for (int bj = 0; bj < 2; ++bj)
#pragma unroll
                    for (int j = 0; j < 8; ++j) { const unsigned gw_ = gv[m][bj][j >> 1]; const float gg = (j & 1) ? __uint_as_float(gw_ & 0xffff0000u) : __uint_as_float(gw_ << 16); acc[ai][bj][m][j >> 2][j & 3] *= gg; }
        }
    }
    __device__ __forceinline__ void operator()(AccRef acc, const pg8::Unit& u, int wr, int wc, int fr, int fq) const {
        const int row0 = u.pm * 256 + wr * 64 + fr, col0 = u.pn * 256 + wc * 32 + 8 * fq;
        const unsigned off0 = (unsigned)((row0 * DM + col0) * 2);
#pragma unroll
        for (int ai = 0; ai < 2; ++ai) {
            u32x4 gv[4][2];
#pragma unroll
            for (int m = 0; m < 4; ++m)
#pragma unroll
                for (int bj = 0; bj < 2; ++bj) gv[m][bj] = ldg<u32x4>(gateb, off0 + (unsigned)((ai * 128 + m * 16) * DM * 2) + bj * 256);
            asm volatile("" ::: "memory");
#pragma unroll
            for (int m = 0; m < 4; ++m)
#pragma unroll
                for (int bj = 0; bj < 2; ++bj) { float r[8];
#pragma unroll
                    for (int j = 0; j < 8; ++j) { const unsigned gw_ = gv[m][bj][j >> 1]; const float gg = (j & 1) ? __uint_as_float(gw_ & 0xffff0000u) : __uint_as_float(gw_ << 16); r[j] = gg * acc[ai][bj][m][j >> 2][j & 3]; }
                    u32x4 w; w.x = pk2(r[0], r[1]); w.y = pk2(r[2], r[3]); w.z = pk2(r[4], r[5]); w.w = pk2(r[6], r[7]);
                    stg<u32x4>(merged, off0 + (unsigned)((ai * 128 + m * 16) * DM * 2) + bj * 256, w); }
        }
    }
};

template <int SRC> struct EpiResid {
    static constexpr bool PERM = true, HAS_MID = false, F16 = false;
    const float* srcp; const float* srcs; const unsigned short* y16src;
    const float* stats_in; const float* g; const float* b; unsigned short* y16dst; bf16* ybfdst; float* y32dst; float* stats_out;
    __device__ __forceinline__ void operator()(AccRef acc, const pg8::Unit& u, int wr, int wc, int fr, int fq) const {
        const int row0 = u.pm * 256 + wr * 64 + fr, col0 = u.pn * 256 + wc * 32 + 8 * fq;
        const bool samp = u.pm >= 128;
        const float* src = samp ? srcs : srcp;
        const unsigned yoff0 = (unsigned)((row0 * DM + col0) * 2);
        const unsigned xoff0 = samp ? 2 * yoff0 - (unsigned)(NSEQ_P * SEQ_P) * DM * 4u : 2 * yoff0;
        float A[8], B[8]; load_row_norms(stats_in, row0, A, B);
        float ssum[8], ssq[8];
#pragma unroll
        for (int i = 0; i < 8; ++i) { ssum[i] = 0.f; ssq[i] = 0.f; }
        u32x4 raw[4], nraw[4];
        if (SRC != 0) {
#pragma unroll
            for (int m = 0; m < 4; ++m) raw[m] = ldg<u32x4>(y16src, yoff0 + (unsigned)((m * 16) * DM * 2));
        }
#pragma unroll
        for (int bj = 0; bj < 2; ++bj) {
            pg8::f32x4 gv[2], bv[2];
#pragma unroll
            for (int n = 0; n < 2; ++n) { gv[n] = ldg<pg8::f32x4>(g, (unsigned)((col0 + bj * 128 + 4 * n) * 4)) * ALPHA; bv[n] = ldg<pg8::f32x4>(b, (unsigned)((col0 + bj * 128 + 4 * n) * 4)) * ALPHA; }
#pragma unroll
            for (int ai = 0; ai < 2; ++ai) {
                pg8::f32x4 yv[4][2];
                if (SRC == 0) {
#pragma unroll
                    for (int m = 0; m < 4; ++m)
#pragma unroll
                        for (int n = 0; n < 2; ++n) yv[m][n] = ldg<pg8::f32x4>(src, xoff0 + (unsigned)((ai * 128 + m * 16) * DM * 4) + bj * 512 + 16 * n);
                } else {
                    if (bj * 2 + ai < 3) { const int nb_ = (bj * 2 + ai + 1) >> 1, na_ = (bj * 2 + ai + 1) & 1;
#pragma unroll
                        for (int m = 0; m < 4; ++m) nraw[m] = ldg<u32x4>(y16src, yoff0 + (unsigned)((na_ * 128 + m * 16) * DM * 2) + nb_ * 256); }
                }
                asm volatile("" ::: "memory");
#pragma unroll
                for (int m = 0; m < 4; ++m) {
                    const float Ar = A[ai * 4 + m], Br = B[ai * 4 + m]; const unsigned yoff = yoff0 + (unsigned)((ai * 128 + m * 16) * DM * 2) + bj * 256;
                    pg8::f32x4 o[2];
#pragma unroll
                    for (int n = 0; n < 2; ++n) {
                        const pg8::f32x4 yy = SRC == 0 ? yv[m][n] : (pg8::f32x4){h2f_lo(raw[m][2 * n]), h2f_hi(raw[m][2 * n]), h2f_lo(raw[m][2 * n + 1]), h2f_hi(raw[m][2 * n + 1])};
                        o[n] = ((yy * Ar + Br) * gv[n] + bv[n]) + acc[ai][bj][m][n];
                        ssum[ai * 4 + m] += (o[n][0] + o[n][1]) + (o[n][2] + o[n][3]); ssq[ai * 4 + m] += (o[n][0] * o[n][0] + o[n][1] * o[n][1]) + (o[n][2] * o[n][2] + o[n][3] * o[n][3]); }
                    if (y32dst) { stg<pg8::f32x4>(y32dst, 2 * yoff, o[0]); stg<pg8::f32x4>(y32dst, 2 * yoff + 16, o[1]); }
                    if (y16dst) { u32x4 w; w.x = pk2h(o[0][0], o[0][1]); w.y = pk2h(o[0][2], o[0][3]); w.z = pk2h(o[1][0], o[1][1]); w.w = pk2h(o[1][2], o[1][3]); stg<u32x4>(y16dst, yoff, w); }
                    if (ybfdst) { u32x4 w; w.x = pk2(o[0][0], o[0][1]); w.y = pk2(o[0][2], o[0][3]); w.z = pk2(o[1][0], o[1][1]); w.w = pk2(o[1][2], o[1][3]); stg<u32x4>(ybfdst, yoff, w); }
                }
                asm volatile("" ::: "memory");
                if (SRC != 0) {
#pragma unroll
                    for (int m = 0; m < 4; ++m) raw[m] = nraw[m]; }
            }
        }
        int fr2 = fr, fq2 = fq; asm volatile("" : "+v"(fr2), "+v"(fq2));
        const unsigned soff0 = (unsigned)((u.pm * 256 + wr * 64 + fr2) * 8 + 4 * fq2);
#pragma unroll
        for (int i = 0; i < 8; ++i) { float s = ssum[i], s2 = ssq[i];
            s += __shfl_xor(s, 16); s += __shfl_xor(s, 32); s2 += __shfl_xor(s2, 16); s2 += __shfl_xor(s2, 32);
            const int iv = (fq2 == 0) ? (int)rintf(s * STAT_Q1) : (int)rintf(s2 * STAT_Q2);
            if (fq2 < 2) __hip_atomic_fetch_add((GAS int*)((GAS char*)stats_out + soff0 + (unsigned)(((i >> 2) * 128 + (i & 3) * 16) * 8)), iv, __ATOMIC_RELAXED, __HIP_MEMORY_SCOPE_AGENT); }
    }
};

struct EpiSwiglu {
    static constexpr bool PERM = true, HAS_MID = false, F16 = false;
    const float* stats; const float* c1; const float* c2; bf16* hid;
    __device__ __forceinline__ void operator()(AccRef acc, const pg8::Unit& u, int wr, int wc, int fr, int fq) const {
        const int row0 = u.pm * 256 + wr * 64 + fr, cl = wc * 32 + 8 * fq, colg = u.pn * 256 + cl;
        float A[8], B[8]; load_row_norms(stats, row0, A, B);
        pg8::f32x4 c1v[2][2], c2v[2][2];
#pragma unroll
        for (int bj = 0; bj < 2; ++bj)
#pragma unroll
            for (int n = 0; n < 2; ++n) { c1v[bj][n] = ldg<pg8::f32x4>(c1, (unsigned)((colg + bj * 128 + 4 * n) * 4)); c2v[bj][n] = ldg<pg8::f32x4>(c2, (unsigned)((colg + bj * 128 + 4 * n) * 4)); }
        asm volatile("" ::: "memory");
        const unsigned hoff0 = (unsigned)((row0 * DFF + u.pn * 128 + cl) * 2);
#pragma unroll
        for (int ai = 0; ai < 2; ++ai)
#pragma unroll
            for (int m = 0; m < 4; ++m) {
                const float Ar = A[ai * 4 + m], Br = B[ai * 4 + m];
                float r[8];
#pragma unroll
                for (int n = 0; n < 2; ++n)
#pragma unroll
                    for (int j = 0; j < 4; ++j) { const float gt = __builtin_fmaf(acc[ai][0][m][n][j], Ar, __builtin_fmaf(c1v[0][n][j], Br, c2v[0][n][j])), up = __builtin_fmaf(acc[ai][1][m][n][j], Ar, __builtin_fmaf(c1v[1][n][j], Br, c2v[1][n][j]));
                        r[4 * n + j] = gt * up * frcp(1.0f + fexp2(gt * -LOG2E)); }
                u32x4 w; w.x = pk2(r[0], r[1]); w.y = pk2(r[2], r[3]); w.z = pk2(r[4], r[5]); w.w = pk2(r[6], r[7]);
                stg<u32x4>(hid, hoff0 + (unsigned)((ai * 128 + m * 16) * DFF * 2), w);
            }
    }
};

__device__ __forceinline__ unsigned off_b(unsigned row, unsigned ch) { return 256u * row + 16u * (ch ^ (((row & 3) << 2) | ((row >> 2) & 3))); }
__device__ __forceinline__ bf16x8 frag_row(const LAS unsigned char* img, int r0, int ks, int lane) { return *(const LAS bf16x8*)(img + off_b(r0 + (lane & 31), 2 * ks + (lane >> 5))); }
__device__ __forceinline__ bf16x8 frag_tr(const LAS unsigned char* img, int k0, int c0, int lane) {
    const unsigned h = lane >> 5, blk = (lane >> 4) & 1, q = (lane & 15) >> 2, p = lane & 3;
    const unsigned ch = (unsigned)(c0 >> 3) + 2 * blk + (p >> 1);
    const s16x4 lo = __builtin_amdgcn_ds_read_tr16_b64_v4i16((LAS s16x4*)(img + off_b(k0 + 8 * h + q, ch) + 8 * (p & 1)));
    const s16x4 hi = __builtin_amdgcn_ds_read_tr16_b64_v4i16((LAS s16x4*)(img + off_b(k0 + 8 * h + 4 + q, ch) + 8 * (p & 1)));
    return (bf16x8){lo[0], lo[1], lo[2], lo[3], hi[0], hi[1], hi[2], hi[3]};
}
__device__ __forceinline__ bf16x8 frag_tr_acc(const LAS unsigned char* img, int k0, int c0, int lane) {
    const unsigned h = lane >> 5, blk = (lane >> 4) & 1, q = (lane & 15) >> 2, p = lane & 3;
    const unsigned ch = (unsigned)(c0 >> 3) + 2 * blk + (p >> 1);
    const s16x4 lo = __builtin_amdgcn_ds_read_tr16_b64_v4i16((LAS s16x4*)(img + off_b(k0 + 4 * h + q, ch) + 8 * (p & 1)));
    const s16x4 hi = __builtin_amdgcn_ds_read_tr16_b64_v4i16((LAS s16x4*)(img + off_b(k0 + 8 + 4 * h + q, ch) + 8 * (p & 1)));
    return (bf16x8){lo[0], lo[1], lo[2], lo[3], hi[0], hi[1], hi[2], hi[3]};
}
__device__ __forceinline__ int crow(int r, int h) { return (r & 3) + 8 * (r >> 2) + 4 * h; }
#define MFMA32(A, B, C) __builtin_amdgcn_mfma_f32_32x32x16_bf16((A), (B), (C), 0, 0, 0)

constexpr int SC_RQ = 0, SC_RG = 16384, SC_VI = 32768, SC_SI = 49152, SC_QT = 81920, SC_KT = 100352, SC_AI = 118784, SC_EM = 128000, SC_EE = 128512, SC_EME = 129024, SC_END = 129536;
constexpr int T_STR = 144, AI_STR = 144;
static_assert(SC_END <= RING_BYTES, "scan LDS");
__device__ __forceinline__ bf16x8 frag_tr144(const LAS unsigned char* img, int k0, int c0, int lane) {
    const unsigned h = lane >> 5, blk = (lane >> 4) & 1, q = (lane & 15) >> 2, p = lane & 3;
    const LAS unsigned char* ad = img + (k0 + 8 * h + q) * T_STR + (c0 + 16 * blk + 4 * p) * 2;
    const s16x4 lo = __builtin_amdgcn_ds_read_tr16_b64_v4i16((LAS s16x4*)ad);
    const s16x4 hi = __builtin_amdgcn_ds_read_tr16_b64_v4i16((LAS s16x4*)(ad + 4 * T_STR));
    return (bf16x8){lo[0], lo[1], lo[2], lo[3], hi[0], hi[1], hi[2], hi[3]};
}
constexpr int SC_BEL = 129536;
static_assert(SC_BEL + 512 <= RING_BYTES, "scan LDS");
template <int MODE>
__device__ __forceinline__ void scan_unit(const Args& a, LAS unsigned char* lds, int rowbase, int head, int dir, int seg, int tid, int wave, int lane) {
    constexpr int L = SEQ_P; constexpr int mode = MODE;
    const unsigned char* hq = a.ws + P_HQ; const unsigned char* gg = a.ws + (dir ? P_GB : P_GF); const unsigned char* hv = a.ws + P_HI;
    unsigned char* oraw = a.ws + (dir ? WS_OBWD : WS_AOUT);
    LAS unsigned char* RQ = lds + SC_RQ; LAS unsigned char* RG = lds + SC_RG; LAS unsigned char* VI = lds + SC_VI; LAS unsigned char* SI = lds + SC_SI;
    LAS unsigned char* QT = lds + SC_QT; LAS unsigned char* KT = lds + SC_KT; LAS unsigned char* AI = lds + SC_AI;
    LAS float* em = (LAS float*)(lds + SC_EM); LAS float* ee = (LAS float*)(lds + SC_EE); LAS float* eme = (LAS float*)(lds + SC_EME); LAS float* bel = (LAS float*)(lds + SC_BEL);
    const int h = lane >> 5, l31 = lane & 31, blk = (lane >> 4) & 1, q4 = (lane & 15) >> 2, p = lane & 3;
    const int tb = wave >> 2, kb = wave & 3;
    constexpr bool passA = MODE == 1;
    bf16x8 Ld[2], Lone;
#pragma unroll
    for (int ksl = 0; ksl < 2; ++ksl)
#pragma unroll
        for (int j = 0; j < 8; ++j) Ld[ksl][j] = (16 * ksl + 8 * h + j <= l31) ? (short)0x3F80 : (short)0;
#pragma unroll
    for (int j = 0; j < 8; ++j) Lone[j] = (short)0x3F80;
    const int kk0 = 32 * ((2 * wave) & 3) + l31, kk1 = 32 * ((2 * wave + 1) & 3) + l31;
    f32x16 S0, S1;
#pragma unroll
    for (int r = 0; r < 16; ++r) { S0[r] = 0.f; S1[r] = 0.f; }
    float dlog0 = 0.f, dlog1 = 0.f;
    if (mode == 2) {
        const int nprev = dir ? (3 - seg) : seg;
        for (int i = 0; i < nprev; ++i) { const int sg = dir ? (3 - i) : i; const int slot = (sg * 8 + head) * 2 + dir;
            const float* E = (const float*)(a.ws + WS_SEGE) + ((size_t)slot * 512 + tid) * 32; const float* D = (const float*)(a.ws + WS_SEGD) + slot * 128;
            const float d0 = fexp2(D[kk0]), d1 = fexp2(D[kk1]);
#pragma unroll
            for (int r4 = 0; r4 < 4; ++r4) { const f32x4 e0 = *(const f32x4*)(E + 4 * r4), e1 = *(const f32x4*)(E + 16 + 4 * r4);
#pragma unroll
                for (int j = 0; j < 4; ++j) { S0[4 * r4 + j] = S0[4 * r4 + j] * d0 + e0[j]; S1[4 * r4 + j] = S1[4 * r4 + j] * d1 + e1[j]; } } }
    }
    constexpr int nch = L / 64;
    u32x4 pq[2], pg[2], pv[2];
    const unsigned colb = (unsigned)((head * 128 + (tid & 15) * 8) * 2);
    auto chunk_off = [&](int cc, int e) -> unsigned { const int c0 = dir ? (L - 64 * (cc + 1)) : 64 * cc; const int i = (tid >> 4) + 32 * e; const int t = dir ? (c0 + 63 - i) : (c0 + i);
        return (unsigned)(rowbase + t) * (unsigned)(HW * 2) + colb; };
#pragma unroll
    for (int e = 0; e < 2; ++e) { const unsigned o = chunk_off(0, e); pq[e] = passA ? (u32x4){0u, 0u, 0u, 0u} : ldg<u32x4>(hq, o); pg[e] = ldg<u32x4>(gg, o); pv[e] = ldg<u32x4>(hv, o); }
    for (int cc = 0; cc < nch; ++cc) {
        const int c0 = dir ? (L - 64 * (cc + 1)) : 64 * cc;
#pragma unroll
        for (int e = 0; e < 2; ++e) { const unsigned ob = off_b((tid >> 4) + 32 * e, tid & 15); *(LAS u32x4*)(RQ + ob) = pq[e]; *(LAS u32x4*)(RG + ob) = pg[e]; *(LAS u32x4*)(VI + ob) = pv[e]; }
        if (cc + 1 < nch) {
#pragma unroll
            for (int e = 0; e < 2; ++e) { const unsigned o = chunk_off(cc + 1, e); if (!passA) pq[e] = ldg<u32x4>(hq, o); pg[e] = ldg<u32x4>(gg, o); pv[e] = ldg<u32x4>(hv, o); }
        }
        __syncthreads();
        { s16x4 graw[4], qraw[4];
#pragma unroll
          for (int g4 = 0; g4 < 4; ++g4) { const unsigned ad = off_b(32 * tb + 8 * g4 + 4 * h + q4, 4 * kb + 2 * blk + (p >> 1)) + 8 * (p & 1);
              graw[g4] = __builtin_amdgcn_ds_read_tr16_b64_v4i16((LAS s16x4*)(RG + ad)); qraw[g4] = __builtin_amdgcn_ds_read_tr16_b64_v4i16((LAS s16x4*)(RQ + ad)); }
          f32x16 c;
#pragma unroll
          for (int r = 0; r < 16; ++r) c[r] = 0.f;
          float bmid, bend = 0.f;
          if (tb == 0) { c = MFMA32(Ld[0], frag_tr(RG, 0, 32 * kb, lane), c); c = MFMA32(Ld[1], frag_tr(RG, 16, 32 * kb, lane), c); bmid = __shfl(c[15], l31 + 32); }
          else { c = MFMA32(Lone, frag_tr(RG, 0, 32 * kb, lane), c); c = MFMA32(Lone, frag_tr(RG, 16, 32 * kb, lane), c); bmid = c[0];
                 c = MFMA32(Ld[0], frag_tr(RG, 32, 32 * kb, lane), c); c = MFMA32(Ld[1], frag_tr(RG, 48, 32 * kb, lane), c); bend = __shfl(c[15], l31 + 32); }
          const int kk = 32 * kb + l31;
#pragma unroll
          for (int g4 = 0; g4 < 4; ++g4) { float qs[4], ks[4];
#pragma unroll
              for (int j = 0; j < 4; ++j) { const float gv = bf2f((unsigned short)graw[g4][j]), qv = bf2f((unsigned short)qraw[g4][j]); const float x = c[4 * g4 + j] - bmid;
                  qs[j] = qv * fexp2(fminf(x, 100.f)); ks[j] = (1.0f - fexp2(gv)) * fexp2(fminf(-x, 100.f)); }
              const unsigned ad = (unsigned)(kk * T_STR + (32 * tb + 8 * g4 + 4 * h) * 2);
              u32x2 wq, wk; wq.x = pk2(qs[0], qs[1]); wq.y = pk2(qs[2], qs[3]); wk.x = pk2(ks[0], ks[1]); wk.y = pk2(ks[2], ks[3]);
              *(LAS u32x2*)(QT + ad) = wq; *(LAS u32x2*)(KT + ad) = wk; }
          if (tb == 1 && h == 0) { em[kk] = fexp2(bmid); ee[kk] = fexp2(bend); eme[kk] = fexp2(bend - bmid); bel[kk] = bend; } }
        __syncthreads();
        if (!passA) {
#pragma unroll
        for (int e = 0; e < 2; ++e) { const int id = 2 * wave + e, vb2 = id >> 2, kk = e ? kk1 : kk0; const float emk = em[kk];
#pragma unroll
            for (int g4 = 0; g4 < 4; ++g4) { const f32x16& S = e ? S1 : S0; u32x2 w; w.x = pk2(S[4 * g4] * emk, S[4 * g4 + 1] * emk); w.y = pk2(S[4 * g4 + 2] * emk, S[4 * g4 + 3] * emk);
                *(LAS u32x2*)(SI + off_b(kk, 4 * vb2 + g4) + 8 * h) = w; } }
        if (wave < 3) { const int sb = wave == 2 ? 1 : 0, tbm = wave == 0 ? 0 : 1; f32x16 c;
#pragma unroll
            for (int r = 0; r < 16; ++r) c[r] = 0.f;
            { bf16x8 ka = frag_tr144(KT, 0, 32 * sb, lane), qa = frag_tr144(QT, 0, 32 * tbm, lane);
#pragma unroll
              for (int ks = 0; ks < 8; ++ks) { bf16x8 kn = ka, qn = qa;
                  if (ks < 7) { kn = frag_tr144(KT, 16 * (ks + 1), 32 * sb, lane); qn = frag_tr144(QT, 16 * (ks + 1), 32 * tbm, lane); }
                  c = MFMA32(ka, qa, c); ka = kn; qa = qn; } }
            const int t = 32 * tbm + l31;
#pragma unroll
            for (int g4 = 0; g4 < 4; ++g4) { float x[4];
#pragma unroll
                for (int j = 0; j < 4; ++j) { const int sx = 32 * sb + 8 * g4 + 4 * h + j; x[j] = (sx <= t) ? c[4 * g4 + j] : 0.f; }
                u32x2 w; w.x = pk2(x[0], x[1]); w.y = pk2(x[2], x[3]); *(LAS u32x2*)(AI + t * AI_STR + (32 * sb + 8 * g4 + 4 * h) * 2) = w; } }
        }
#pragma unroll
        for (int e = 0; e < 2; ++e) { const int id = 2 * wave + e, vb2 = id >> 2, kk = e ? kk1 : kk0; f32x16 c;
#pragma unroll
            for (int r = 0; r < 16; ++r) c[r] = 0.f;
#pragma unroll
            for (int ks = 0; ks < 4; ++ks) c = MFMA32(frag_tr(VI, 16 * ks, 32 * vb2, lane), *(const LAS bf16x8*)(KT + kk * T_STR + (16 * ks + 8 * h) * 2), c);
            const float eek = ee[kk], emek = eme[kk];
            if (e) { dlog1 += bel[kk];
#pragma unroll
                for (int r = 0; r < 16; ++r) S1[r] = S1[r] * eek + c[r] * emek; }
            else { dlog0 += bel[kk];
#pragma unroll
                for (int r = 0; r < 16; ++r) S0[r] = S0[r] * eek + c[r] * emek; } }
        __syncthreads();
        if (!passA) { const int vb = kb; f32x16 c;
#pragma unroll
          for (int r = 0; r < 16; ++r) c[r] = 0.f;
          const LAS unsigned char* aip = AI + (32 * tb + l31) * AI_STR + 16 * h;
          { bf16x8 xa = frag_tr144(QT, 0, 32 * tb, lane), xb = frag_tr(SI, 0, 32 * vb, lane);
#pragma unroll
            for (int ks = 0; ks < 8; ++ks) { bf16x8 na, nb;
                if (ks < 7) { na = frag_tr144(QT, 16 * (ks + 1), 32 * tb, lane); nb = frag_tr(SI, 16 * (ks + 1), 32 * vb, lane); }
                else { na = *(const LAS bf16x8*)aip; nb = frag_tr(VI, 0, 32 * vb, lane); }
                c = MFMA32(xa, xb, c); xa = na; xb = nb; }
            { bf16x8 na = *(const LAS bf16x8*)(aip + 32), nb = frag_tr(VI, 16, 32 * vb, lane); c = MFMA32(xa, xb, c); xa = na; xb = nb; }
            if (tb) { bf16x8 na = *(const LAS bf16x8*)(aip + 64), nb = frag_tr(VI, 32, 32 * vb, lane); c = MFMA32(xa, xb, c); xa = na; xb = nb;
                      na = *(const LAS bf16x8*)(aip + 96); nb = frag_tr(VI, 48, 32 * vb, lane); c = MFMA32(xa, xb, c); xa = na; xb = nb; }
            c = MFMA32(xa, xb, c); }
          const unsigned lo = (unsigned)((head * 128 + 32 * vb + l31) * 2) + (unsigned)((dir ? 4 - 4 * h : 4 * h) * (HW * 2));
          const int tu0 = __builtin_amdgcn_readfirstlane(rowbase + (dir ? c0 + 63 - 32 * tb - 4 : c0 + 32 * tb));
#pragma unroll
          for (int r = 0; r < 16; r += 2) { const unsigned w = pk2(c[r], c[r + 1]);
              const int d0 = (r & 3) + 8 * (r >> 2), d1 = d0 + 1;
              unsigned char* b0 = oraw + (size_t)(unsigned)(dir ? tu0 - d0 : tu0 + d0) * (size_t)(HW * 2); unsigned char* b1 = oraw + (size_t)(unsigned)(dir ? tu0 - d1 : tu0 + d1) * (size_t)(HW * 2);
              stg<unsigned short>(b0, lo, (unsigned short)(w & 0xffffu)); stg<unsigned short>(b1, lo, (unsigned short)(w >> 16)); }
          __syncthreads(); }
    }
    if (passA) {
        const int slot = (seg * 8 + head) * 2 + dir;
        float* E = (float*)(a.ws + WS_SEGE) + ((size_t)slot * 512 + tid) * 32; float* D = (float*)(a.ws + WS_SEGD) + slot * 128;
#pragma unroll
        for (int r4 = 0; r4 < 4; ++r4) { *(f32x4*)(E + 4 * r4) = (f32x4){S0[4 * r4], S0[4 * r4 + 1], S0[4 * r4 + 2], S0[4 * r4 + 3]}; *(f32x4*)(E + 16 + 4 * r4) = (f32x4){S1[4 * r4], S1[4 * r4 + 1], S1[4 * r4 + 2], S1[4 * r4 + 3]}; }
        if (wave < 2 && h == 0) { D[kk0] = dlog0; D[kk1] = dlog1; }
    }
}

__device__ __forceinline__ void finalize_a(const Args& a, int l, int gw, int ngw, int lane, int m_lo, int m_hi) {
    bf16* of = (bf16*)(a.ws + WS_AOUT); const bf16* ob = (const bf16*)(a.ws + WS_OBWD); const bf16* hg = (const bf16*)(a.ws + P_HG);
    const float* ng = a.hg_norm_g + l * 128;
    const int c8 = (lane & 15) * 8;
    float gv[8];
#pragma unroll
    for (int j = 0; j < 8; ++j) gv[j] = ng[c8 + j];
    const unsigned lo = (unsigned)(((lane >> 4) * 128 + c8) * 2);
    struct Rows { u32x4 f[2], b[2], g[2]; };
    auto load = [&](Rows& R, int m) {
#pragma unroll
        for (int p = 0; p < 2; ++p) { const unsigned o = (unsigned)m * (unsigned)(HW * 2) + lo + (unsigned)(p * 1024); R.f[p] = ldg<u32x4>(of, o); R.b[p] = ldg<u32x4>(ob, o); R.g[p] = ldg<u32x4>(hg, o); } };
    auto finish = [&](const Rows& R, int m) {
#pragma unroll
        for (int p = 0; p < 2; ++p) {
            float x[8], ss = 0.f;
#pragma unroll
            for (int j = 0; j < 8; ++j) { const unsigned fw = R.f[p][j >> 1], bw = R.b[p][j >> 1]; const float fv = (j & 1) ? __uint_as_float(fw & 0xffff0000u) : __uint_as_float(fw << 16);
                const float bv = (j & 1) ? __uint_as_float(bw & 0xffff0000u) : __uint_as_float(bw << 16); x[j] = fv + bv; ss += x[j] * x[j]; }
            ss += __shfl_xor(ss, 1); ss += __shfl_xor(ss, 2); ss += __shfl_xor(ss, 4); ss += __shfl_xor(ss, 8);
            const float rs = 1.0f / sqrtf(ss * (1.0f / 128.0f) + RMS_EPS);
            float r[8];
#pragma unroll
            for (int j = 0; j < 8; ++j) { const unsigned gw_ = R.g[p][j >> 1]; const float gt = (j & 1) ? __uint_as_float(gw_ & 0xffff0000u) : __uint_as_float(gw_ << 16); r[j] = x[j] * rs * gv[j] * gt; }
            u32x4 w; w.x = pk2(r[0], r[1]); w.y = pk2(r[2], r[3]); w.z = pk2(r[4], r[5]); w.w = pk2(r[6], r[7]);
            stg<u32x4>(of, (unsigned)m * (unsigned)(HW * 2) + lo + (unsigned)(p * 1024), w); } };
    Rows A, B;
    int m = m_lo + gw;
    if (m < m_hi) load(A, m);
    for (; m < m_hi; m += 2 * ngw) {
        const bool hb = m + ngw < m_hi;
        if (hb) load(B, m + ngw);
        asm volatile("" ::: "memory");
        finish(A, m);
        if (!hb) break;
        if (m + 2 * ngw < m_hi) load(A, m + 2 * ngw);
        asm volatile("" ::: "memory");
        finish(B, m + ngw);
    }
}

constexpr int AT_K = 0, AT_V = 32768, AT_BUF = 65536;
static_assert(2 * AT_BUF <= RING_BYTES, "attention LDS");
__device__ __forceinline__ void attn_unit(const Args& a, int l, LAS unsigned char* lds, int unit, int tid, int wave, int lane) {
    const int nb = unit >> 2, hk = (unit >> 1) & 1, hh = unit & 1;
    int n, N; if (nb < 256) { n = nb & 15; N = 16; } else { n = nb - 256; N = 64; }
    const int qhead = 4 * hk + 2 * hh + (wave >> 2), qt = wave & 3, h = lane >> 5, l31 = lane & 31;
    const bf16* aq = (const bf16*)(a.ws + P_AQ); const unsigned char* ak = a.ws + P_AK; const unsigned char* av = a.ws + P_AV; unsigned char* bo = a.ws + WS_BOUT;
    const int qi = 32 * qt + l31;
    const size_t qrow = (size_t)nb * 128 + qi;
    const int kb_lo = n > 0 ? n - 1 : 0, kb_hi = n + 1 < N ? n + 1 : N - 1;
    auto stage = [&](int kb, int b) {
        const unsigned rowoff = (unsigned)((nb + (kb - n)) * 128) * (unsigned)(KVW * 2) + (unsigned)(hk * 256);
#pragma unroll
        for (int e = 0; e < 4; ++e) { const unsigned row = (unsigned)(e * 32 + (tid >> 4)), ch = (unsigned)(tid & 15) ^ (((row & 3) << 2) | ((row >> 2) & 3));
            const unsigned go = rowoff + row * (unsigned)(KVW * 2) + ch * 16u;
            __builtin_amdgcn_global_load_lds((const GAS unsigned*)((const GAS unsigned char*)ak + go), (LAS unsigned*)(lds + b * AT_BUF + AT_K + e * 8192 + wave * 1024), 16, 0, 0);
            __builtin_amdgcn_global_load_lds((const GAS unsigned*)((const GAS unsigned char*)av + go), (LAS unsigned*)(lds + b * AT_BUF + AT_V + e * 8192 + wave * 1024), 16, 0, 0); } };
    __syncthreads();
    stage(kb_lo, 0);
    bf16x8 qf[8];
#pragma unroll
    for (int ks = 0; ks < 8; ++ks) qf[ks] = *(const bf16x8*)(aq + qrow * HW + qhead * 128 + 16 * ks + 8 * h);
    f32x16 O[4];
#pragma unroll
    for (int c = 0; c < 4; ++c)
#pragma unroll
        for (int r = 0; r < 16; ++r) O[c][r] = 0.f;
    float mrun = a.attn_sink[l * 8 + qhead] * LOG2E, lrun = 1.0f;
    int b = 0;
    for (int kb = kb_lo; kb <= kb_hi; ++kb, b ^= 1) {
        asm volatile("s_waitcnt vmcnt(0)" ::: "memory");
        __syncthreads();
        if (kb < kb_hi) stage(kb + 1, b ^ 1);
        const LAS unsigned char* KI = lds + b * AT_BUF + AT_K; const LAS unsigned char* VI = lds + b * AT_BUF + AT_V;
        const int rel = kb - n;
        for (int kt = 0; kt < 4; ++kt) {
            if ((rel < 0 && kt < qt) || (rel > 0 && kt > qt)) continue;
            f32x16 s;
#pragma unroll
            for (int r = 0; r < 16; ++r) s[r] = 0.f;
#pragma unroll
            for (int ks = 0; ks < 8; ++ks) s = MFMA32(frag_row(KI, 32 * kt, ks, lane), qf[ks], s);
            if (rel != 0 && kt == qt) {
#pragma unroll
                for (int r = 0; r < 16; ++r) { const int jj = 32 * kt + crow(r, h); const bool ok = rel < 0 ? (jj >= qi) : (jj <= qi); s[r] = ok ? s[r] : -__builtin_inff(); } }
            float mx = s[0];
#pragma unroll
            for (int r = 1; r < 16; ++r) mx = fmaxf(mx, s[r]);
            mx = fmaxf(mx, __shfl_xor(mx, 32));
            const float mnew = fmaxf(mrun, mx), alpha = fexp2(mrun - mnew); mrun = mnew;
            float ps = 0.f;
#pragma unroll
            for (int r = 0; r < 16; ++r) { s[r] = fexp2(s[r] - mnew); ps += s[r]; }
            ps += __shfl_xor(ps, 32);
            lrun = lrun * alpha + ps;
            bf16x8 pf[2];
#pragma unroll
            for (int sx = 0; sx < 2; ++sx) { u32x4 w; w.x = pk2(s[8 * sx], s[8 * sx + 1]); w.y = pk2(s[8 * sx + 2], s[8 * sx + 3]); w.z = pk2(s[8 * sx + 4], s[8 * sx + 5]); w.w = pk2(s[8 * sx + 6], s[8 * sx + 7]);
                pf[sx] = __builtin_bit_cast(bf16x8, w); }
            if (__builtin_amdgcn_ballot_w64(alpha != 1.0f) != 0ull) {
#pragma unroll
                for (int c = 0; c < 4; ++c)
#pragma unroll
                    for (int r = 0; r < 16; ++r) O[c][r] *= alpha; }
#pragma unroll
            for (int c = 0; c < 4; ++c)
#pragma unroll
                for (int sx = 0; sx < 2; ++sx) O[c] = MFMA32(frag_tr_acc(VI, 32 * kt + 16 * sx, 32 * c, lane), pf[sx], O[c]);
        }
    }
    const float inv = 1.0f / lrun;
    const unsigned oo = (unsigned)(((unsigned)qrow * HW + qhead * 128 + 4 * h) * 2);
#pragma unroll
    for (int c = 0; c < 4; ++c)
#pragma unroll
        for (int g4 = 0; g4 < 4; ++g4) { u32x2 w; w.x = pk2(O[c][4 * g4] * inv, O[c][4 * g4 + 1] * inv); w.y = pk2(O[c][4 * g4 + 2] * inv, O[c][4 * g4 + 3] * inv);
            stg<u32x2>(bo, oo + (unsigned)((32 * c + 8 * g4) * 2), w); }
}


__device__ __forceinline__ void final_ln(const Args& a, int gw, int ngw, int lane) {
    const float* st = (const float*)(a.ws + WS_STATS + 8 * STATS_BYTES); const float* g = a.ln2_g + 3 * DM; const float* b = a.ln2_b + 3 * DM;
    for (int m = gw; m < MTOK; m += ngw) { float A, B; row_norm(st, m, A, B);
        f32x4* yr = (f32x4*)(a.out + (size_t)m * DM) + lane;
#pragma unroll
        for (int j = 0; j < 8; ++j) { const f32x4 v = yr[64 * j], gv = *((const f32x4*)g + lane + 64 * j), bv = *((const f32x4*)b + lane + 64 * j); yr[64 * j] = (v * A + B) * gv + bv; } }
}

constexpr int N_PHASES = 1 + 8 * DEPTH + 1;
constexpr int FIN_EARLY = 10 * SEQ_P;
#ifndef PH_MASK
#define PH_MASK 0xfff
#endif
#define PHON(j) (((PH_MASK) >> (j)) & 1)
__global__ void __launch_bounds__(NTHREADS, 2) enc_fwd(Args a0) {
    extern __shared__ __attribute__((aligned(16))) unsigned char lds_raw[];
    LAS unsigned char* lds = (LAS unsigned char*)lds_raw;
    volatile LAS unsigned* MISC = (volatile LAS unsigned*)(lds + MISC_OFF);
    const int tid0 = threadIdx.x, wave = __builtin_amdgcn_readfirstlane(tid0 >> 6);
    const int G = gridDim.x, bx = blockIdx.x;
    const int vcu = (G % 8 == 0) ? (bx % 8) * (G / 8) + bx / 8 : bx;
    const int gw = vcu * NWAVES + wave, ngw = G * NWAVES;
    for (int u = tid0; u < (LDS_BYTES - MISC_OFF) / 4; u += NTHREADS) ((LAS unsigned*)(lds + MISC_OFF))[u] = 0u;
    __syncthreads();
    XcdBarrier bar; bar.bar = (unsigned*)(a0.ws + WS_CTL); bar.x = 0; bar.st = nullptr;
#if !MK_PER_PHASE_LAUNCH
    bar = xcd_barrier_post((unsigned*)(a0.ws + WS_CTL), MISC + 8, tid0 == 0);
#endif
    const int lo = a0.ph_lo, hi = a0.ph_hi;
#define IN(k) (lo <= (k) && (k) < hi)
#define LAUNDER() int tid = wave * 64 + lane_id(); asm volatile("" : "+v"(tid)); const int lane = tid & 63; Args a = a0; asm volatile("" : "+s"(a.ws), "+s"(a.out))
#if MK_PER_PHASE_LAUNCH
#define SEAM(k) do { } while (0)
#else
#define SEAM(k) do { if ((k) + 1 < hi) xcd_barrier(bar, wave == 0 && lane_id() == 0); } while (0)
#endif
    if (PHON(8) && IN(0)) { LAUNDER(); prologue(a, gw, ngw, lane); SEAM(0); }

#ifndef PROBE_MIX
#define PROBE_MIX 0
#endif
#if PROBE_MIX
    for (int it_ = 0; it_ < 2 * DEPTH; ++it_) {
        int it = it_; asm volatile("" : "+s"(it)); int l = it >> 1; const int sub = it & 1;
#else
    for (int l_ = 0; l_ < DEPTH; ++l_) {
        int l = l_; asm volatile("" : "+s"(l));
        constexpr int sub = -1;
#endif
        const bool do_scan = sub != 1 || PROBE_MIX != 3, do_attn = sub != 1 || PROBE_MIX != 2, do_fin = sub != 1 || PROBE_MIX != 3;
        const int pb = 1 + 8 * l;
#define LOCALS() LAUNDER(); unsigned char* wsw = a.ws + WS_W; float* cv = (float*)(a.ws + WS_CVEC + (size_t)l * CVEC_LAYER); \
        const float* stats_in = (const float*)(a.ws + WS_STATS + (size_t)(l == 0 ? 0 : 2 * l) * STATS_BYTES); \
        float* stats_1 = (float*)(a.ws + WS_STATS + (size_t)(1 + 2 * l) * STATS_BYTES); float* stats_2 = (float*)(a.ws + WS_STATS + (size_t)(2 + 2 * l) * STATS_BYTES); \
        bf16* ybf = (bf16*)(a.ws + WS_YBF); (void)wsw; (void)cv; (void)stats_in; (void)stats_1; (void)stats_2; (void)ybf
        if (sub != 1 && PHON(0) && IN(pb + 0)) { LOCALS(); convert_layer(a, l, lds, gw, ngw, wave, lane); SEAM(pb + 0); }
        if (sub != 1 && PHON(1) && IN(pb + 1)) { LOCALS();
            pg8::Gemm g{ybf, nullptr, (const bf16*)(wsw + W_IN), MTOK, NPROJ, DM, DM}; pg8::StaticOrder S; S.init(MTOK, NPROJ, G, bx);
            EpiProj E{a.ws, stats_in, cv, cv + NPROJ, (const float*)(a.ws + WS_LB) + l * 2048};
            pg8::gemm_phase<EpiProj, pg8::StaticOrder>(lds, g, S, E, wave);
            SEAM(pb + 1);
        }
        if (PHON(2) && IN(pb + 2)) { LOCALS();
            if (do_scan) for (int u = bx; u < 256; u += G) {
                if (u < 48) { const int hd = u & 7, dir = (u >> 3) & 1, seg = (u >> 4) + dir; scan_unit<1>(a, lds, NSEQ_P * SEQ_P + seg * SEQ_P, hd, dir, seg, tid, wave, lane); }
                else { const int v = u - 48; scan_unit<0>(a, lds, (v >> 4) * SEQ_P, (v >> 1) & 7, v & 1, 0, tid, wave, lane); }
            }
            if (do_attn && G == 256) { const int an0 = bx < 48 ? 3 : 1, a00 = bx < 48 ? 3 * bx : 144 + (bx - 48); for (int j = 0; j < an0; ++j) attn_unit(a, l, lds, a00 + j, tid, wave, lane); }
            __syncthreads();
            xcd_barrier(bar, wave == 0 && lane_id() == 0);
            if (do_scan) for (int u = bx; u < 112; u += G) {
                if (u < 48) { const int v = 208 + u; scan_unit<0>(a, lds, (v >> 4) * SEQ_P, (v >> 1) & 7, v & 1, 0, tid, wave, lane); }
                else { const int v = u - 48, seg = v >> 4; scan_unit<2>(a, lds, NSEQ_P * SEQ_P + seg * SEQ_P, (v >> 1) & 7, v & 1, seg, tid, wave, lane); }
            }
            { int a0 = bx, astr = G, an = (1280 - bx + G - 1) / G, aex = -1;
              if (G == 256) { astr = 1; if (bx < 112) { a0 = 352 + 2 * bx; an = 2; } else { const int w = bx - 112; a0 = 576 + (w < 128 ? 5 * w : 640 + 4 * (w - 128)); an = w < 128 ? 5 : 4; } }
              if (do_attn) for (int j = 0; j < an + (aex >= 0 ? 1 : 0); ++j) attn_unit(a, l, lds, j < an ? a0 + j * astr : aex, tid, wave, lane);
              if (do_fin && G == 256 && bx >= 112) finalize_a(a, l, (bx - 112) * NWAVES + wave, 144 * NWAVES, lane, 0, FIN_EARLY); }
            __syncthreads();
            SEAM(pb + 2);
        }
        if (sub != 0 && PHON(3) && IN(pb + 3)) { LOCALS(); finalize_a(a, l, gw, ngw, lane, G == 256 ? FIN_EARLY : 0, MTOK); SEAM(pb + 3); }
        if (sub != 0 && PHON(4) && IN(pb + 4)) { LOCALS();
            pg8::Gemm g{(const bf16*)(a.ws + WS_AOUT), (const bf16*)(a.ws + WS_BOUT), (const bf16*)(wsw + W_A), MTOK, DM, DM, HW}; pg8::StaticOrder S; S.init(MTOK, DM, G, bx);
            EpiMergeF E{(const bf16*)(a.ws + P_GA), (const bf16*)(a.ws + P_GBB), (bf16*)(a.ws + WS_MERGED)};
            pg8::gemm_phase<EpiMergeF, pg8::StaticOrder>(lds, g, S, E, wave);
            SEAM(pb + 4);
        }
        if (sub != 0 && PHON(5) && IN(pb + 5)) { LOCALS();
            pg8::Gemm g{(const bf16*)(a.ws + WS_MERGED), nullptr, (const bf16*)(wsw + W_OUT), MTOK, DM, DM, DM}; pg8::StaticOrder S; S.init(MTOK, DM, G, bx);
            const float* gi = l == 0 ? a.ln_in_g : a.ln2_g + (size_t)(l - 1) * DM; const float* bi = l == 0 ? a.ln_in_b : a.ln2_b + (size_t)(l - 1) * DM;
            if (l == 0) { EpiResid<0> E{a.xp, a.xs, nullptr, stats_in, gi, bi, (unsigned short*)(a.ws + P_GA), (bf16*)(a.ws + P_GBB), nullptr, stats_1};
                pg8::gemm_phase<EpiResid<0>, pg8::StaticOrder>(lds, g, S, E, wave); }
            else { EpiResid<1> E{nullptr, nullptr, (const unsigned short*)a.out, stats_in, gi, bi, (unsigned short*)(a.ws + P_GA), (bf16*)(a.ws + P_GBB), nullptr, stats_1};
                pg8::gemm_phase<EpiResid<1>, pg8::StaticOrder>(lds, g, S, E, wave); }
            SEAM(pb + 5);
        }
        if (sub != 0 && PHON(6) && IN(pb + 6)) { LOCALS();
            pg8::Gemm g{(const bf16*)(a.ws + P_GBB), nullptr, (const bf16*)(wsw + W_FIN), MTOK, NFFN, DM, DM}; pg8::StaticOrder S; S.init(MTOK, NFFN, G, bx);
            EpiSwiglu E{stats_1, cv + 2 * NPROJ, cv + 2 * NPROJ + NFFN, (bf16*)(a.ws + WS_HID)};
            pg8::gemm_phase<EpiSwiglu, pg8::StaticOrder>(lds, g, S, E, wave);
            SEAM(pb + 6);
        }
        if (sub != 0 && PHON(7) && IN(pb + 7)) { LOCALS();
            pg8::Gemm g{(const bf16*)(a.ws + WS_HID), nullptr, (const bf16*)(wsw + W_FOUT), MTOK, DM, DFF, DFF}; pg8::StaticOrder S; S.init(MTOK, DM, G, bx);
            EpiResid<1> E{nullptr, nullptr, (const unsigned short*)(a.ws + P_GA), stats_1, a.ln1_g + (size_t)l * DM, a.ln1_b + (size_t)l * DM,
                          l == DEPTH - 1 ? nullptr : (unsigned short*)a.out, l == DEPTH - 1 ? nullptr : ybf, l == DEPTH - 1 ? a.out : nullptr, stats_2};
            pg8::gemm_phase<EpiResid<1>, pg8::StaticOrder>(lds, g, S, E, wave);
            SEAM(pb + 7);
        }
    }
    if (PHON(9) && IN(N_PHASES - 1)) { LAUNDER(); final_ln(a, gw, ngw, lane); }
#undef IN
#undef SEAM
#undef LAUNDER
#undef LOCALS
}

extern "C" void kernel_launch(void* const* d_in, const int* in_sizes, int n_in, void* d_out, int out_size, void* d_ws, size_t ws_size, hipStream_t stream) {
    static int grid = 0;
    if (grid == 0) {
        if (n_in != 17 || out_size != MTOK * DM || ws_size < WS_END) { fprintf(stderr, "kernel_launch: unexpected shapes (n_in %d out %d ws %zu need %zu)\n", n_in, out_size, ws_size, (size_t)WS_END); grid = -1; return; }
        int dev = 0, cus = 0, per_cu = 0;
        if (hipGetDevice(&dev) != hipSuccess || hipDeviceGetAttribute(&cus, hipDeviceAttributeMultiprocessorCount, dev) != hipSuccess) { grid = -1; return; }
        if (hipFuncSetAttribute((const void*)enc_fwd, hipFuncAttributeMaxDynamicSharedMemorySize, LDS_BYTES) != hipSuccess) { fprintf(stderr, "kernel_launch: hipFuncSetAttribute failed\n"); grid = -1; return; }
        if (hipOccupancyMaxActiveBlocksPerMultiprocessor(&per_cu, (const void*)enc_fwd, NTHREADS, LDS_BYTES) != hipSuccess || per_cu < 1) { fprintf(stderr, "kernel_launch: occupancy query says %d\n", per_cu); }
        (void)hipGetLastError();
        grid = cus;
    }
    if (grid < 0) return;
    (void)hipMemsetAsync((char*)d_ws, 0, ZERO_BYTES, stream);
    Args a{};
    a.xp = (const float*)d_in[0]; a.xs = (const float*)d_in[1]; a.ln_in_g = (const float*)d_in[2]; a.ln_in_b = (const float*)d_in[3]; a.w_in = (const float*)d_in[4];
    a.lb_logits = (const float*)d_in[5]; a.hg_norm_g = (const float*)d_in[6]; a.attn_sink = (const float*)d_in[7]; a.w_a = (const float*)d_in[8]; a.w_b = (const float*)d_in[9];
    a.w_out = (const float*)d_in[10]; a.ln1_g = (const float*)d_in[11]; a.ln1_b = (const float*)d_in[12]; a.w_ffn_in = (const float*)d_in[13]; a.w_ffn_out = (const float*)d_in[14];
    a.ln2_g = (const float*)d_in[15]; a.ln2_b = (const float*)d_in[16]; a.out = (float*)d_out; a.ws = (unsigned char*)d_ws;
#if MK_PER_PHASE_LAUNCH
    for (int p = 0; p < N_PHASES; ++p) { a.ph_lo = p; a.ph_hi = p + 1; hipLaunchKernelGGL(enc_fwd, dim3(grid), dim3(NTHREADS), LDS_BYTES, stream, a); }
#else
    a.ph_lo = 0; a.ph_hi = N_PHASES;
    hipLaunchKernelGGL(enc_fwd, dim3(grid), dim3(NTHREADS), LDS_BYTES, stream, a);
#endif
}
```

```cpp
#include <hip/hip_runtime.h>
#include <cstdio>
#include <cstdint>

#ifndef MK_PER_PHASE_LAUNCH
#define MK_PER_PHASE_LAUNCH 0
#endif

namespace pg8 {
#define PG8_LAS __attribute__((address_space(3)))
typedef unsigned short bf16_t;
typedef short bf16x8 __attribute__((ext_vector_type(8)));
typedef _Float16 f16x8 __attribute__((ext_vector_type(8)));
typedef float f32x4 __attribute__((ext_vector_type(4)));
typedef unsigned u32x4 __attribute__((ext_vector_type(4)));
typedef unsigned u32x2 __attribute__((ext_vector_type(2)));
constexpr int BM = 256, BK = 64, HALF = 128, HTB = HALF * BK * 2, STAGE_BYTES = 8 * HTB, NXCD = 8, WGM = 4;
constexpr int SM_OFF = STAGE_BYTES + 1024, SM_HALF = 6144;
__device__ __forceinline__ void dma16(const void* gbase, unsigned goff, PG8_LAS unsigned char* dst) {
    __builtin_amdgcn_global_load_lds((const __attribute__((address_space(1))) unsigned*)((const __attribute__((address_space(1))) unsigned char*)gbase + goff), (PG8_LAS unsigned*)dst, 16, 0, 0); }

__host__ __device__ __forceinline__ int lds_byte(int r, int c) { const int st = (r >> 4) * 2 + (c >> 5), rr = r & 15, cc = c & 31, ob = rr * 64 + cc * 2; return st * 1024 + (ob ^ (((ob >> 9) & 1) << 5)); }
__host__ __device__ __forceinline__ void stage_rc(int b, int& R, int& C) { const int st = b / 1024, sb = b % 1024, swz = sb ^ (((sb >> 9) & 1) << 5); R = (st >> 1) * 16 + swz / 64; C = (st & 1) * 32 + (swz % 64) / 2; }
__host__ __device__ __forceinline__ int perm32(int rho) { const int n = rho >> 4, i = rho & 15; return 8 * (i >> 2) + 4 * n + (i & 3); }

struct Unit { int pm, pn; };
struct Gemm { const bf16_t* A; const bf16_t* A2; const bf16_t* Bt; int M, N, K, lda; };

struct StaticOrder {
    int nM, nN, nwg, G, c;
    __host__ __device__ void init(int M, int N, int G_, int c_) { nM = M / BM; nN = N / BM; nwg = nM * nN; G = G_; c = c_; }
    __host__ __device__ bool next(int i, Unit& u) const {
        const long L = (long)i * G + c; if (L >= nwg) return false;
        int wgid = (int)L; { const int q = nwg / NXCD, r = nwg % NXCD, xcd = wgid % NXCD, off = wgid / NXCD; wgid = (xcd < r ? xcd * (q + 1) : r * (q + 1) + (xcd - r) * q) + off; }
        const int nig = WGM * nN, gid = wgid / nig, fm = gid * WGM, gsz = (nM - fm) < WGM ? (nM - fm) : WGM;
        u.pm = fm + ((wgid % nig) % gsz); u.pn = (wgid % nig) / gsz; return true;
    }
    __device__ __forceinline__ void a_ready(const Unit&) const {}
    __device__ __forceinline__ void done(const Unit&) const {}
};

__device__ __forceinline__ unsigned cvt_pk_bf16(float lo, float hi) { unsigned r; asm volatile("v_cvt_pk_bf16_f32 %0, %1, %2" : "=v"(r) : "v"(lo), "v"(hi)); return r; }
__device__ __forceinline__ unsigned cvt_pk_f16(float lo, float hi) { unsigned r; asm volatile("v_cvt_pk_f16_f32 %0, %1, %2" : "=v"(r) : "v"(lo), "v"(hi)); return r; }

#ifndef GP_ALIGN
#define GP_ALIGN true
#endif
#ifndef GP_SP2
#define GP_SP2 true
#endif
template <class Epi, class Sched, bool ALIGN_EPI = GP_ALIGN, bool SP2 = GP_SP2>
__device__ __forceinline__ void gemm_phase(PG8_LAS unsigned char* lds, const Gemm g_, const Sched& S, const Epi& E, int wid_) {
    int tid_; asm volatile("v_mbcnt_lo_u32_b32 %0, -1, 0\n\tv_mbcnt_hi_u32_b32 %0, -1, %0" : "=v"(tid_)); tid_ += wid_ * 64;
    Gemm g = g_; asm volatile("" : "+s"(g.A), "+s"(g.A2), "+s"(g.Bt));
    const int tid = tid_, wid = __builtin_amdgcn_readfirstlane(tid >> 6), lane = tid & 63, wr = wid >> 2, wc = wid & 3, fr = lane & 15, fq = lane >> 4;
    const int K = g.K, nt = K / BK;
    unsigned voffA[2], voffB[2];
#define PG8_VOFF(tidv) do { _Pragma("unroll") for (int i = 0; i < 2; ++i) { int R, C; stage_rc((tidv) * 16 + i * 8192, R, C); const int Rb = Epi::PERM ? ((R & ~31) + perm32(R & 31)) : R; \
        voffA[i] = (unsigned)(R * g.lda + C) * 2u; voffB[i] = (unsigned)(Rb * K + C) * 2u; } } while (0)
    PG8_VOFF(tid);
    constexpr unsigned kstep = BK * 2;
    const unsigned hstep = (unsigned)(HALF * K * 2), hstepA = (unsigned)(HALF * g.lda * 2);
    const unsigned tstep = 2 * hstep, tstepA = 2 * hstepA;
    const bool dualA = g.A2 != nullptr; const int ntA = dualA ? nt / 2 : nt; const int a2delta = dualA ? (int)(((const char*)g.A2 - (const char*)g.A) - (ptrdiff_t)ntA * (ptrdiff_t)kstep) : 0;
    const unsigned ldsw = (unsigned)wid * 1024u;
    const int aoff = lds_byte(wr * 64 + fr, fq * 8), boff = lds_byte(wc * 32 + fr, fq * 8);
#define PG8_SA(b, h) (((b) * 2 + (h)) * HTB)
#define PG8_SB(b, h) ((4 + (b) * 2 + (h)) * HTB)
#define PG8_STAGE(bufoff, gbase, voff) do { _Pragma("unroll") for (int _i = 0; _i < 2; ++_i) \
        __builtin_amdgcn_global_load_lds((const unsigned*)((const char*)(gbase) + (voff)[_i]), (PG8_LAS unsigned*)(lds + (bufoff) + ldsw + _i * 8192), 16, 0, 0); } while (0)
#define PG8_LDA(dst, b, h) do { _Pragma("unroll") for (int m = 0; m < 4; ++m) _Pragma("unroll") for (int k = 0; k < 2; ++k) dst[m][k] = *(const PG8_LAS bf16x8*)(lds + PG8_SA(b, h) + aoff + m * 2048 + k * 1024); } while (0)
#define PG8_LDB(dst, b, h) do { _Pragma("unroll") for (int n = 0; n < 2; ++n) _Pragma("unroll") for (int k = 0; k < 2; ++k) dst[n][k] = *(const PG8_LAS bf16x8*)(lds + PG8_SB(b, h) + boff + n * 2048 + k * 1024); } while (0)
#define PG8_MMA(ai, bj, At, Bt) do { __builtin_amdgcn_s_setprio(1); _Pragma("unroll") for (int m = 0; m < 4; ++m) _Pragma("unroll") for (int n = 0; n < 2; ++n) _Pragma("unroll") for (int k = 0; k < 2; ++k) { \
        if constexpr (Epi::F16) acc[ai][bj][m][n] = __builtin_amdgcn_mfma_f32_16x16x32_f16(__builtin_bit_cast(f16x8, Bt[n][k]), __builtin_bit_cast(f16x8, At[m][k]), acc[ai][bj][m][n], 0, 0, 0); \
        else acc[ai][bj][m][n] = __builtin_amdgcn_mfma_f32_16x16x32_bf16(Bt[n][k], At[m][k], acc[ai][bj][m][n], 0, 0, 0); } __builtin_amdgcn_s_setprio(0); } while (0)
#define PG8_WAIT_V(n) asm volatile("s_waitcnt vmcnt(" #n ")" ::: "memory")
#define PG8_WAIT_L(n) asm volatile("s_waitcnt lgkmcnt(" #n ")" ::: "memory")
#define PG8_BAR __builtin_amdgcn_s_barrier()
#define PG8_SCHED __builtin_amdgcn_sched_barrier(0)
    Unit cur, nxt; int ui = 0;
    if (!S.next(0, cur)) return;
    f32x4 acc[2][2][4][2];
#pragma unroll
    for (int a = 0; a < 2; ++a)
#pragma unroll
        for (int b = 0; b < 2; ++b)
#pragma unroll
            for (int m = 0; m < 4; ++m)
#pragma unroll
                for (int n = 0; n < 2; ++n) acc[a][b][m][n] = (f32x4){0.f, 0.f, 0.f, 0.f};
    bf16x8 At[4][2], B0[2][2], B1[2][2];
    const char* cA = (const char*)g.A + (size_t)cur.pm * tstepA; const char* cB = (const char*)g.Bt + (size_t)cur.pn * tstep;
    PG8_LAS unsigned char* smb = lds + SM_OFF;
    E.prefetch(smb, cur, wid, lane);
    S.a_ready(cur);
    if constexpr (SP2) {
        PG8_STAGE(PG8_SB(0, 0), cB, voffB); PG8_STAGE(PG8_SB(0, 1), cB + hstep, voffB); PG8_STAGE(PG8_SA(0, 0), cA, voffA); PG8_STAGE(PG8_SA(0, 1), cA + hstepA, voffA);
        if (wr == 1) PG8_BAR;
        PG8_WAIT_V(2); PG8_BAR;
        PG8_STAGE(PG8_SB(1, 0), cB + kstep, voffB); PG8_STAGE(PG8_SA(1, 0), cA + kstep, voffA); PG8_STAGE(PG8_SB(1, 1), cB + hstep + kstep, voffB);
        PG8_WAIT_V(6); PG8_BAR;
    } else {
        PG8_STAGE(PG8_SB(0, 0), cB, voffB); PG8_STAGE(PG8_SA(0, 0), cA, voffA); PG8_STAGE(PG8_SB(0, 1), cB + hstep, voffB); PG8_STAGE(PG8_SA(0, 1), cA + hstepA, voffA);
        if (wr == 1) PG8_BAR;
        PG8_WAIT_V(4); PG8_BAR;
        PG8_STAGE(PG8_SB(1, 0), cB + kstep, voffB); PG8_STAGE(PG8_SA(1, 0), cA + kstep, voffA); PG8_STAGE(PG8_SB(1, 1), cB + hstep + kstep, voffB);
        PG8_WAIT_V(6); PG8_BAR;
    }
    for (;;) {
        const bool has_next = S.next(ui + 1, nxt);
        const char* nA = has_next ? (const char*)g.A + (size_t)nxt.pm * tstepA : cA; const char* nB = has_next ? (const char*)g.Bt + (size_t)nxt.pn * tstep : cB;
        for (int t = 0; t < nt; t += 2) {
            const bool last = (t == nt - 2);
            const char* a1 = cA + (ptrdiff_t)((t >= ntA ? a2delta : 0) + (int)((t + 1) * kstep));
            const char* a2 = last ? nA : cA + (ptrdiff_t)((t + 2 >= ntA ? a2delta : 0) + (int)((t + 2) * kstep)); const char* b2 = last ? nB : cB + (size_t)((t + 2) * kstep);
            const char* a3 = a2 + kstep; const char* b3 = b2 + kstep;
            if (last && has_next) S.a_ready(nxt);
            if constexpr (Epi::HAS_MID) { if (t == ntA) { int fr_ = fr, fq_ = fq; asm volatile("" : "+v"(fr_), "+v"(fq_)); E.mid(acc, cur, wr, wc, fr_, fq_); } }
            if constexpr (SP2) {
            PG8_LDB(B0, 0, 0); PG8_LDB(B1, 0, 1); PG8_SCHED; PG8_LDA(At, 0, 0); PG8_STAGE(PG8_SA(1, 1), a1 + hstepA, voffA);
            PG8_WAIT_V(8); PG8_WAIT_L(0); PG8_BAR; PG8_MMA(0, 0, At, B0); PG8_MMA(0, 1, At, B1); PG8_BAR; PG8_SCHED;
            PG8_LDA(At, 0, 1); PG8_STAGE(PG8_SB(0, 0), b2, voffB); PG8_STAGE(PG8_SB(0, 1), b2 + hstep, voffB); PG8_STAGE(PG8_SA(0, 0), a2, voffA);
            PG8_WAIT_V(8); PG8_WAIT_L(0); PG8_BAR; PG8_MMA(1, 0, At, B0); PG8_MMA(1, 1, At, B1); PG8_BAR; PG8_SCHED;
            PG8_LDB(B0, 1, 0); PG8_LDB(B1, 1, 1); PG8_SCHED; PG8_LDA(At, 1, 0); PG8_STAGE(PG8_SA(0, 1), a2 + hstepA, voffA);
            PG8_WAIT_V(8); PG8_WAIT_L(0); PG8_BAR; PG8_MMA(0, 0, At, B0); PG8_MMA(0, 1, At, B1); PG8_BAR; PG8_SCHED;
            PG8_LDA(At, 1, 1); PG8_STAGE(PG8_SB(1, 0), b3, voffB); PG8_STAGE(PG8_SB(1, 1), b3 + hstep, voffB); PG8_STAGE(PG8_SA(1, 0), a3, voffA);
            PG8_WAIT_V(8); PG8_WAIT_L(0); PG8_BAR; PG8_MMA(1, 0, At, B0); PG8_MMA(1, 1, At, B1); PG8_BAR; PG8_SCHED;
            } else {
            PG8_LDB(B0, 0, 0); PG8_SCHED; PG8_LDA(At, 0, 0); PG8_STAGE(PG8_SA(1, 1), a1 + hstepA, voffA);
            PG8_WAIT_L(8); PG8_BAR; PG8_WAIT_L(0); PG8_MMA(0, 0, At, B0); PG8_BAR; PG8_SCHED;
            PG8_LDB(B1, 0, 1); PG8_STAGE(PG8_SB(0, 0), b2, voffB);
            PG8_BAR; PG8_WAIT_L(0); PG8_MMA(0, 1, At, B1); PG8_BAR;
            PG8_LDA(At, 0, 1); PG8_STAGE(PG8_SA(0, 0), a2, voffA);
            PG8_BAR; PG8_WAIT_L(0); PG8_MMA(1, 0, At, B0); PG8_BAR; PG8_SCHED;
            PG8_STAGE(PG8_SB(0, 1), b2 + hstep, voffB);
            PG8_WAIT_V(6); PG8_BAR; PG8_MMA(1, 1, At, B1); PG8_BAR;
            PG8_LDB(B0, 1, 0); PG8_SCHED; PG8_LDA(At, 1, 0); PG8_STAGE(PG8_SA(0, 1), a2 + hstepA, voffA);
            PG8_WAIT_L(8); PG8_BAR; PG8_WAIT_L(0); PG8_MMA(0, 0, At, B0); PG8_BAR; PG8_SCHED;
            PG8_LDB(B1, 1, 1); PG8_STAGE(PG8_SB(1, 0), b3, voffB);
            PG8_BAR; PG8_WAIT_L(0); PG8_MMA(0, 1, At, B1); PG8_BAR;
            PG8_LDA(At, 1, 1); PG8_STAGE(PG8_SA(1, 0), a3, voffA);
            PG8_BAR; PG8_WAIT_L(0); PG8_MMA(1, 0, At, B0); PG8_BAR; PG8_SCHED;
            PG8_STAGE(PG8_SB(1, 1), b3 + hstep, voffB);
            PG8_WAIT_V(6); PG8_BAR; PG8_MMA(1, 1, At, B1); PG8_BAR;
            }
        }
        if constexpr (ALIGN_EPI) { if (wr == 0) PG8_BAR; }
        { int fr_ = fr, fq_ = fq; asm volatile("" : "+v"(fr_), "+v"(fq_));
          E(acc, cur, wr, wc, fr_, fq_, smb + (ui & 1) * SM_HALF); }
        if (!has_next) break;
        { int l2; asm volatile("v_mbcnt_lo_u32_b32 %0, -1, 0\n\tv_mbcnt_hi_u32_b32 %0, -1, %0" : "=v"(l2)); E.prefetch(smb + ((ui + 1) & 1) * SM_HALF, nxt, wid, l2); }
        { int tid2; asm volatile("v_mbcnt_lo_u32_b32 %0, -1, 0\n\tv_mbcnt_hi_u32_b32 %0, -1, %0" : "=v"(tid2)); tid2 += wid_ * 64; PG8_VOFF(tid2); }
#pragma unroll
        for (int a = 0; a < 2; ++a)
#pragma unroll
            for (int b = 0; b < 2; ++b)
#pragma unroll
                for (int m = 0; m < 4; ++m)
#pragma unroll
                    for (int n = 0; n < 2; ++n) acc[a][b][m][n] = (f32x4){0.f, 0.f, 0.f, 0.f};
        cur = nxt; cA = nA; cB = nB; ++ui;
        if constexpr (ALIGN_EPI) { if (wr == 1) PG8_BAR; }
    }
    PG8_WAIT_V(0);
    if constexpr (!ALIGN_EPI) { if (wr == 0) PG8_BAR; }
    PG8_BAR;
#undef PG8_VOFF
#undef PG8_SA
#undef PG8_SB
#undef PG8_STAGE
#undef PG8_LDA
#undef PG8_LDB
#undef PG8_MMA
#undef PG8_WAIT_V
#undef PG8_WAIT_L
#undef PG8_BAR
#undef PG8_SCHED
}
}

constexpr int NWAVES = 8, NTHREADS = NWAVES * 64;
constexpr int DM = 2048, DEPTH = 4, NPROJ = 10752, DFF = 5632, NFFN = 2 * DFF;
constexpr int SEQ_P = 2048, NSEQ_P = 16, SEQ_S = 8192;
constexpr int MTOK = NSEQ_P * SEQ_P + SEQ_S;
constexpr int HW = 1024;
constexpr int KVW = 256;
constexpr float LN_EPS = 1e-5f, RMS_EPS = 1e-6f;
constexpr float ALPHA = 1.6817928305074292f;
constexpr float LOG2E = 1.4426950408889634f;
constexpr float QSCALE = 0.08838834764831845f * 1.4426950408889634f;

constexpr size_t MiB = 1u << 20;
constexpr size_t WS_CTL = 0;
constexpr size_t WS_STATS = 64 * 1024;
constexpr size_t STATS_BYTES = (size_t)MTOK * 8;
constexpr size_t WS_CVEC = WS_STATS + 9 * STATS_BYTES;
constexpr size_t CVEC_LAYER = (size_t)(2 * NPROJ + 2 * NFFN) * 4;
constexpr size_t ZERO_BYTES = 4 * MiB;
static_assert(WS_CVEC + DEPTH * CVEC_LAYER <= ZERO_BYTES, "zeroed region");
constexpr size_t WS_LB = 4 * MiB;
constexpr size_t WS_COS = 5 * MiB, WS_SIN = 7 * MiB;
constexpr size_t WS_SEGE = 9 * MiB;
constexpr size_t WS_SEGD = 13 * MiB;
constexpr size_t WS_W = 14 * MiB;
constexpr size_t W_IN = 0, W_A = W_IN + (size_t)NPROJ * DM * 2, W_B = W_A + (size_t)DM * HW * 2, W_OUT = W_B + (size_t)DM * HW * 2,
                 W_FIN = W_OUT + (size_t)DM * DM * 2, W_FOUT = W_FIN + (size_t)NFFN * DM * 2, W_END = W_FOUT + (size_t)DM * DFF * 2;
static_assert(W_END == 124 * MiB, "weights per layer");
constexpr size_t WS_YBF = WS_W + 124 * MiB;
static_assert(WS_SEGE + 64 * 512 * 32 * 4 <= WS_SEGD && WS_SEGD + 64 * 128 * 4 <= WS_W, "segment state buffers");
constexpr size_t WS_PROJ = WS_YBF + 160 * MiB;
constexpr size_t SZ1K = (size_t)MTOK * HW * 2;
constexpr size_t P_HQ = WS_PROJ, P_GF = P_HQ + SZ1K, P_GB = P_GF + SZ1K, P_HI = P_GB + SZ1K, P_HG = P_HI + SZ1K, P_AQ = P_HG + SZ1K,
                 P_AK = P_AQ + SZ1K, P_AV = P_AK + SZ1K / 4, P_GA = P_AV + SZ1K / 4, P_GBB = P_GA + 2 * SZ1K, P_END = P_GBB + 2 * SZ1K;
constexpr size_t WS_MERGED = P_HQ;
constexpr size_t WS_HID = P_HQ;
static_assert((size_t)MTOK * DFF * 2 <= P_END - P_HQ, "hidden overlay");
constexpr size_t WS_AOUT = P_END, WS_BOUT = WS_AOUT + SZ1K, WS_OBWD = WS_BOUT + SZ1K, WS_END = WS_OBWD + SZ1K;
static_assert(WS_END <= 1408 * MiB, "workspace");

constexpr int RING_BYTES = 131072;
constexpr int MISC_OFF = RING_BYTES;
constexpr int LDS_BYTES = 147456;

#define GAS __attribute__((address_space(1)))
#define LAS __attribute__((address_space(3)))
typedef unsigned short bf16;
typedef float f32x4 __attribute__((ext_vector_type(4)));
typedef float f32x16 __attribute__((ext_vector_type(16)));
typedef short bf16x8 __attribute__((ext_vector_type(8)));
typedef short s16x4 __attribute__((ext_vector_type(4)));
typedef unsigned u32x4 __attribute__((ext_vector_type(4)));
typedef unsigned u32x2 __attribute__((ext_vector_type(2)));
typedef float f32x2 __attribute__((ext_vector_type(2)));
typedef int i32x2 __attribute__((ext_vector_type(2)));
constexpr float STAT_Q1 = 8192.f, STAT_S1 = 1.0f / 8192.f, STAT_Q2 = 512.f, STAT_S2 = 1.0f / 512.f;

__device__ __forceinline__ float bf2f(unsigned short b) { return __uint_as_float(((unsigned)b) << 16); }
__device__ __forceinline__ unsigned f2bf(float f) { unsigned u = __float_as_uint(f); return (u + 0x7fffu + ((u >> 16) & 1u)) >> 16; }
__device__ __forceinline__ unsigned pk2(float lo, float hi) { return pg8::cvt_pk_bf16(lo, hi); }
__device__ __forceinline__ unsigned pk2h(float lo, float hi) { return pg8::cvt_pk_f16(lo, hi); }
typedef _Float16 f16x2 __attribute__((ext_vector_type(2)));
__device__ __forceinline__ float h2f_lo(unsigned u) { return (float)__builtin_bit_cast(f16x2, u)[0]; }
__device__ __forceinline__ float h2f_hi(unsigned u) { return (float)__builtin_bit_cast(f16x2, u)[1]; }
__device__ __forceinline__ float fexp2(float x) { return __builtin_amdgcn_exp2f(x); }
__device__ __forceinline__ float frcp(float x) { return __builtin_amdgcn_rcpf(x); }
template <int FRAC> __device__ __forceinline__ float qfix(float v) { return __builtin_rintf(v * (float)(1 << FRAC)) * (1.0f / (float)(1 << FRAC)); }
__device__ __forceinline__ float sigmoidf_(float x) { return frcp(1.0f + fexp2(-x * LOG2E)); }
__device__ __forceinline__ float siluf_(float x) { return x * sigmoidf_(x); }

__device__ __forceinline__ int lane_id() { int l; asm volatile("v_mbcnt_lo_u32_b32 %0, -1, 0\n\tv_mbcnt_hi_u32_b32 %0, -1, %0" : "=v"(l)); return l; }

#define XB_TMO      128
#define XB_XCNT(j)  (256  + 64 * (j))
#define XB_XSUB(j)  (1280 + 64 * (j))
#define XB_XGEN(j)  (2304 + 64 * (j))
#define XB_TOP      3328
#define XB_TOPGEN   3392
#define XCD_BAR_WORDS 3456
#define XB_SPIN_CAP (1u << 24)
__device__ __forceinline__ unsigned xb_ld(unsigned* p)              { return __hip_atomic_load(p, __ATOMIC_RELAXED, __HIP_MEMORY_SCOPE_AGENT); }
__device__ __forceinline__ unsigned xb_add(unsigned* p, unsigned v) { return __hip_atomic_fetch_add(p, v, __ATOMIC_RELAXED, __HIP_MEMORY_SCOPE_AGENT); }
__device__ __forceinline__ unsigned xb_xcc_id() { return (unsigned)__builtin_amdgcn_s_getreg((3 << 11) | 20) & 0xFu; }
#define XB_SPIN(cond, bar) do { unsigned _sp = 0; while (cond) { __builtin_amdgcn_s_sleep(1); \
    if ((++_sp & 255u) == 0u) { if (xb_ld(&(bar)[XB_TMO])) break; if (_sp > XB_SPIN_CAP) { atomicAdd(&(bar)[XB_TMO], 1u); break; } } } } while (0)
struct XcdBarrier { unsigned* bar; unsigned x; volatile LAS unsigned* st; };
__device__ __forceinline__ XcdBarrier xcd_barrier_post(unsigned* bar, volatile LAS unsigned* st, bool leader) {
    XcdBarrier b; b.bar = bar; b.x = xb_xcc_id(); b.st = st;
    if (leader) (void)xb_add(&bar[XB_XCNT(b.x)], 1u);
    return b;
}
__device__ __forceinline__ void xcd_barrier_complete(unsigned* bar, unsigned x, unsigned& nloc, unsigned& nx) {
    const unsigned G = gridDim.x * gridDim.y * gridDim.z;
    unsigned sum, cnt, mine, sp = 0u;
    for (;;) {
        sum = 0u; cnt = 0u; mine = 0u;
#pragma unroll
        for (unsigned j = 0; j < 16; ++j) { const unsigned c = xb_ld(&bar[XB_XCNT(j)]); sum += c; cnt += (c > 0u) ? 1u : 0u; mine = (j == x) ? c : mine; }
        if (sum == G) break;
        __builtin_amdgcn_s_sleep(1);
        if ((++sp & 255u) == 0u) { if (xb_ld(&bar[XB_TMO])) break; if (sp > XB_SPIN_CAP) { atomicAdd(&bar[XB_TMO], 1u); break; } }
    }
    nloc = mine > 0u ? mine : 1u; nx = cnt > 0u ? cnt : 1u;
}
__device__ __forceinline__ void xcd_barrier(const XcdBarrier& b, bool leader) {
    asm volatile("s_waitcnt vmcnt(0)" ::: "memory");
    __syncthreads();
    if (leader) {
        unsigned* bar = b.bar;
        __builtin_amdgcn_s_waitcnt(0);
        unsigned nloc = b.st[0], nx = b.st[1];
        if (nloc == 0u) { xcd_barrier_complete(bar, b.x, nloc, nx); b.st[0] = nloc; b.st[1] = nx; }
        const unsigned old = xb_add(&bar[XB_XSUB(b.x)], 1u);
        const unsigned gen = old / nloc;
        if (old + 1u == (gen + 1u) * nloc) {
            __builtin_amdgcn_fence(__ATOMIC_RELEASE, "agent");
            asm volatile("s_waitcnt vmcnt(0)" ::: "memory");
            const unsigned og = xb_add(&bar[XB_TOP], 1u);
            const unsigned tg = og / nx;
            if (og + 1u == (tg + 1u) * nx) xb_add(&bar[XB_TOPGEN], 1u);
            else XB_SPIN(xb_ld(&bar[XB_TOPGEN]) == tg, bar);
            __builtin_amdgcn_fence(__ATOMIC_ACQUIRE, "agent");
            xb_add(&bar[XB_XGEN(b.x)], 1u);
            asm volatile("s_waitcnt vmcnt(0)" ::: "memory");
        } else {
            XB_SPIN(xb_ld(&bar[XB_XGEN(b.x)]) == gen, bar);
            __builtin_amdgcn_fence(__ATOMIC_ACQUIRE, "agent");
            asm volatile("s_waitcnt vmcnt(0)" ::: "memory");
        }
    }
    __syncthreads();
}

struct Args {
    const float* xp; const float* xs; const float* ln_in_g; const float* ln_in_b; const float* w_in; const float* lb_logits; const float* hg_norm_g; const float* attn_sink;
    const float* w_a; const float* w_b; const float* w_out; const float* ln1_g; const float* ln1_b; const float* w_ffn_in; const float* w_ffn_out; const float* ln2_g; const float* ln2_b;
    float* out; unsigned char* ws; int ph_lo, ph_hi;
};

__device__ __forceinline__ float wave_sum(float v) {
#pragma unroll
    for (int o = 1; o < 64; o <<= 1) v += __shfl_xor(v, o);
    return v;
}

__device__ __forceinline__ void row_norm(const float* st, int row, float& A, float& B) {
    const int2 si = *(const int2*)(st + 2 * (size_t)row); float2 s; s.x = (float)si.x * STAT_S1; s.y = (float)si.y * STAT_S2;
    const float mean = s.x * (1.0f / DM); const float var = fmaxf(s.y * (1.0f / DM) - mean * mean, 0.f);
    const float rstd = 1.0f / sqrtf(var + LN_EPS); A = rstd; B = -mean * rstd;
}

template <int MAPKIND>
__device__ __forceinline__ int colmap(int n) {
    if (MAPKIND == 1) { if (n >= 6656) { const int t = (n - 6656) >> 8, i = (n - 6656) & 255; return (i < 128) ? (6656 + 128 * t + i) : (8704 + 128 * t + (i - 128)); }
        if (n >= 5120 && n < 6400) { const int hb = n & ~127, p = n & 127, j8 = p >> 3, e = p & 7; return hb + ((e < 4) ? (4 * j8 + e) : (64 + 4 * j8 + (e - 4))); } return n; }
    if (MAPKIND == 2) { const int t = n >> 8, i = n & 255; return (i < 128) ? (128 * t + i) : (DFF + 128 * t + (i - 128)); }
    return n;
}
template <int MAPKIND, bool FOLD>
__device__ __forceinline__ void transpose_item(const float* W, int K, int N, bf16* WT, int ldk, const float* gain, const float* bias, float* c1, float* c2, LAS float* scr, int item, int lane) {
    const int nblk = N / 32, kb = item / nblk, nb = item % nblk, k0 = 64 * kb, n0 = 32 * nb;
    const int ncol = colmap<MAPKIND>(n0 + (lane & 31));
    float s1 = 0.f, s2 = 0.f;
#pragma unroll 8
    for (int i = 0; i < 32; ++i) { const int kk = 2 * i + (lane >> 5); float w = W[(size_t)(k0 + kk) * N + ncol];
        if (FOLD) { const float gk = gain[k0 + kk], bk = bias[k0 + kk]; s2 += bk * w; w *= gk; s1 += __uint_as_float(f2bf(w) << 16); }
        scr[kk * 33 + (lane & 31)] = w; }
    if (FOLD) { s1 += __shfl_xor(s1, 32); s2 += __shfl_xor(s2, 32); if (lane < 32) { atomicAdd(c1 + n0 + lane, qfix<19>(s1)); atomicAdd(c2 + n0 + lane, qfix<21>(s2)); } }
    asm volatile("s_waitcnt lgkmcnt(0)" ::: "memory");
    const int c = lane & 7;
#pragma unroll
    for (int j = 0; j < 4; ++j) { const int n = (lane >> 3) + 8 * j; const LAS float* s = scr + (8 * c) * 33 + n;
        u32x4 o; o.x = pk2(s[0 * 33], s[1 * 33]); o.y = pk2(s[2 * 33], s[3 * 33]); o.z = pk2(s[4 * 33], s[5 * 33]); o.w = pk2(s[6 * 33], s[7 * 33]);
        *(u32x4*)(WT + (size_t)(n0 + n) * ldk + k0 + 8 * c) = o; }
    asm volatile("s_waitcnt lgkmcnt(0)" ::: "memory");
}

__device__ __forceinline__ void convert_layer(const Args& a, int l, LAS unsigned char* lds, int gw, int ngw, int wave, int lane) {
    LAS float* scr = (LAS float*)(lds + wave * 16384);
    unsigned char* wsw = a.ws + WS_W;
    float* cv = (float*)(a.ws + WS_CVEC + (size_t)l * CVEC_LAYER);
    const float* g_in = l == 0 ? a.ln_in_g : a.ln2_g + (size_t)(l - 1) * DM;
    const float* b_in = l == 0 ? a.ln_in_b : a.ln2_b + (size_t)(l - 1) * DM;
    constexpr int I_IN = (DM / 64) * (NPROJ / 32), I_A = (HW / 64) * (DM / 32), I_OUT = (DM / 64) * (DM / 32), I_FIN = (DM / 64) * (NFFN / 32), I_FOUT = (DFF / 64) * (DM / 32);
    constexpr int NITEMS = I_IN + 2 * I_A + I_OUT + I_FIN + I_FOUT;
    for (int it = gw; it < NITEMS; it += ngw) {
        int r = it;
        if (r < I_IN) { transpose_item<1, true>(a.w_in + (size_t)l * DM * NPROJ, DM, NPROJ, (bf16*)(wsw + W_IN), DM, g_in, b_in, cv, cv + NPROJ, scr, r, lane); continue; } r -= I_IN;
        if (r < I_FIN) { transpose_item<2, true>(a.w_ffn_in + (size_t)l * DM * NFFN, DM, NFFN, (bf16*)(wsw + W_FIN), DM, a.ln1_g + (size_t)l * DM, a.ln1_b + (size_t)l * DM, cv + 2 * NPROJ, cv + 2 * NPROJ + NFFN, scr, r, lane); continue; } r -= I_FIN;
        if (r < I_FOUT) { transpose_item<0, false>(a.w_ffn_out + (size_t)l * DFF * DM, DFF, DM, (bf16*)(wsw + W_FOUT), DFF, nullptr, nullptr, nullptr, nullptr, scr, r, lane); continue; } r -= I_FOUT;
        if (r < I_OUT) { transpose_item<0, false>(a.w_out + (size_t)l * DM * DM, DM, DM, (bf16*)(wsw + W_OUT), DM, nullptr, nullptr, nullptr, nullptr, scr, r, lane); continue; } r -= I_OUT;
        if (r < I_A) { transpose_item<0, false>(a.w_a + (size_t)l * HW * DM, HW, DM, (bf16*)(wsw + W_A), DM, nullptr, nullptr, nullptr, nullptr, scr, r, lane); continue; } r -= I_A;
        transpose_item<0, false>(a.w_b + (size_t)l * HW * DM, HW, DM, (bf16*)(wsw + W_A) + HW, DM, nullptr, nullptr, nullptr, nullptr, scr, r, lane);
    }
}

__device__ __forceinline__ const float* xrow_ptr(const Args& a, int m) { return m < NSEQ_P * SEQ_P ? a.xp + (size_t)m * DM : a.xs + (size_t)(m - NSEQ_P * SEQ_P) * DM; }

__device__ __forceinline__ void prologue(const Args& a, int gw, int ngw, int lane) {
    { float* lb = (float*)(a.ws + WS_LB);
      for (int c = gw * 64 + lane; c < 2048; c += ngw * 64) {
          float v[DEPTH], mx = -1e30f, s = 0.f;
#pragma unroll
          for (int l = 0; l < DEPTH; ++l) { v[l] = a.lb_logits[l * 2048 + c]; mx = fmaxf(mx, v[l]); }
#pragma unroll
          for (int l = 0; l < DEPTH; ++l) { v[l] = expf(v[l] - mx); s += v[l]; }
          float cum = 0.f;
#pragma unroll
          for (int l = 0; l < DEPTH; ++l) { const float p = v[l] / s; cum += p; lb[l * 2048 + c] = cum - v[0] / s; }
      } }
    { float* ct = (float*)(a.ws + WS_COS); float* st = (float*)(a.ws + WS_SIN);
      for (int i = gw * 64 + lane; i < SEQ_S * 64; i += ngw * 64) { const int pos = i >> 6, j = i & 63;
          const double inv = pow(10000.0, -(double)(2 * j) / 128.0); const double ang = (double)pos * inv; ct[i] = (float)cos(ang); st[i] = (float)sin(ang); } }
    { float* st0 = (float*)(a.ws + WS_STATS); bf16* ybf = (bf16*)(a.ws + WS_YBF);
      for (int m = gw; m < MTOK; m += ngw) {
          const f32x4* xr = (const f32x4*)xrow_ptr(a, m) + lane; float s = 0.f, s2 = 0.f;
          unsigned long long* o8 = (unsigned long long*)(ybf + (size_t)m * DM) + lane;
#pragma unroll
          for (int j = 0; j < 8; ++j) { const f32x4 v = xr[64 * j]; s += (v.x + v.y) + (v.z + v.w); s2 += (v.x * v.x + v.y * v.y) + (v.z * v.z + v.w * v.w);
              o8[64 * j] = (unsigned long long)pk2(v.x, v.y) | ((unsigned long long)pk2(v.z, v.w) << 32); }
          s = wave_sum(s); s2 = wave_sum(s2);
          if (lane == 0) { ((int*)st0)[2 * (size_t)m] = (int)rintf(s * STAT_Q1); ((int*)st0)[2 * (size_t)m + 1] = (int)rintf(s2 * STAT_Q2); }
      } }
}

typedef pg8::f32x4 (&AccRef)[2][2][4][2];
template <class T> __device__ __forceinline__ T ldg(const void* base, unsigned off) { return *(const GAS T*)((const GAS char*)base + off); }
template <class T> __device__ __forceinline__ void stg(void* base, unsigned off, T v) { *(GAS T*)((GAS char*)base + off) = v; }
__device__ __forceinline__ void row_norm_o(const float* st, unsigned off8, float& A, float& B) {
    const i32x2 si = ldg<i32x2>(st, off8); f32x2 s; s.x = (float)si.x * STAT_S1; s.y = (float)si.y * STAT_S2;
    const float mean = s.x * (1.0f / DM); const float var = fmaxf(s.y * (1.0f / DM) - mean * mean, 0.f);
    const float rstd = 1.0f / sqrtf(var + LN_EPS); A = rstd; B = -mean * rstd;
}

__device__ __forceinline__ void load_row_norms(const float* st, int row0, float (&A)[8], float (&B)[8]) {
    i32x2 sv[8];
#pragma unroll
    for (int i = 0; i < 8; ++i) sv[i] = ldg<i32x2>(st, (unsigned)((row0 + (i >> 2) * 128 + (i & 3) * 16) * 8));
#pragma unroll
    for (int i = 0; i < 8; ++i) { const float mean = (float)sv[i].x * (STAT_S1 / DM); const float var = fmaxf((float)sv[i].y * (STAT_S2 / DM) - mean * mean, 0.f);
        const float rstd = 1.0f / sqrtf(var + LN_EPS); A[i] = rstd; B[i] = -mean * rstd; }
}

__device__ __forceinline__ void lds_row_norms(const LAS unsigned char* sm, int rl0, float (&A)[8], float (&B)[8]) {
    i32x2 sv[8];
#pragma unroll
    for (int i = 0; i < 8; ++i) sv[i] = *(const LAS i32x2*)(sm + (rl0 + (i >> 2) * 128 + (i & 3) * 16) * 8);
#pragma unroll
    for (int i = 0; i < 8; ++i) { const float mean = (float)sv[i].x * (STAT_S1 / DM); const float var = fmaxf((float)sv[i].y * (STAT_S2 / DM) - mean * mean, 0.f);
        const float rstd = 1.0f / sqrtf(var + LN_EPS); A[i] = rstd; B[i] = -mean * rstd; }
}
__device__ __forceinline__ void prefetch_stats(const float* stats, int pm, LAS unsigned char* sm, int wid, int lane) {
    if (wid == 0) { pg8::dma16(stats, (unsigned)(pm * 2048 + lane * 16), sm); pg8::dma16(stats, (unsigned)(pm * 2048 + 1024 + lane * 16), sm + 1024); } }

struct EpiProj {
    static constexpr bool PERM = true, HAS_MID = false, F16 = false;
    unsigned char* ws; const float* stats; const float* c1; const float* c2; const float* lb;
    __device__ __forceinline__ void prefetch(LAS unsigned char* sm, const pg8::Unit& u, int wid, int lane) const {
        prefetch_stats(stats, u.pm, sm, wid, lane);
        if (wid == 1) { pg8::dma16(c1, (unsigned)(u.pn * 1024 + lane * 16), sm + 2048); pg8::dma16(c2, (unsigned)(u.pn * 1024 + lane * 16), sm + 3072); }
        if (wid == 2 && u.pn >= 4 && u.pn < 12) pg8::dma16(lb, (unsigned)((u.pn - 4) * 1024 + lane * 16), sm + 4096);
    }
    __device__ __forceinline__ void operator()(AccRef acc, const pg8::Unit& u, int wr, int wc, int fr, int fq, const LAS unsigned char* sm) const {
        const int pn = u.pn, row0 = u.pm * 256 + wr * 64 + fr, cl = wc * 32 + 8 * fq, colg = pn * 256 + cl;
        int type, ldc, dcol; size_t dbase;
        if (pn < 4)       { type = 0; dbase = P_HQ;  ldc = HW;  dcol = pn * 256; }
        else if (pn < 8)  { type = 1; dbase = P_GF;  ldc = HW;  dcol = (pn - 4) * 256; }
        else if (pn < 12) { type = 1; dbase = P_GB;  ldc = HW;  dcol = (pn - 8) * 256; }
        else if (pn < 16) { type = 2; dbase = P_HI;  ldc = HW;  dcol = (pn - 12) * 256; }
        else if (pn < 20) { type = 0; dbase = P_HG;  ldc = HW;  dcol = (pn - 16) * 256; }
        else if (pn < 24) { type = 3; dbase = P_AQ;  ldc = HW;  dcol = (pn - 20) * 256; }
        else if (pn < 25) { type = 4; dbase = P_AK;  ldc = KVW; dcol = 0; }
        else if (pn < 26) { type = 2; dbase = P_AV;  ldc = KVW; dcol = 0; }
        else              { type = 5; dbase = P_GA;  ldc = DM;  dcol = (pn - 26) * 128; }
        unsigned char* dst = ws + dbase;
        const unsigned doff0 = (unsigned)((row0 * ldc + dcol + cl) * 2), dstep = (unsigned)(16 * ldc * 2);
        const int pos0 = (u.pm < 128 ? ((u.pm & 7) * 256) : ((u.pm - 128) * 256)) + wr * 64 + fr;
        const unsigned roff0 = (unsigned)(pos0 * 256 + (16 * wc + 4 * fq) * 4);
        const float* cost = (const float*)(ws + WS_COS); const float* sint = (const float*)(ws + WS_SIN);
        float A[8], B[8]; lds_row_norms(sm, wr * 64 + fr, A, B);
        if (type == 5) {
            unsigned char* dstb = ws + P_GBB;
            pg8::f32x4 c1v[2][2], c2v[2][2];
#pragma unroll
            for (int bj = 0; bj < 2; ++bj)
#pragma unroll
                for (int n = 0; n < 2; ++n) { c1v[bj][n] = *(const LAS pg8::f32x4*)(sm + 2048 + (cl + bj * 128 + 4 * n) * 4); c2v[bj][n] = *(const LAS pg8::f32x4*)(sm + 3072 + (cl + bj * 128 + 4 * n) * 4) * (-LOG2E); }
            asm volatile("" ::: "memory");
#pragma unroll
            for (int ai = 0; ai < 2; ++ai)
#pragma unroll
                for (int m = 0; m < 4; ++m) {
                    const float Ar = -LOG2E * A[ai * 4 + m], Br = -LOG2E * B[ai * 4 + m];
                    float rt[8], gb[8];
#pragma unroll
                    for (int n = 0; n < 2; ++n)
#pragma unroll
                        for (int j = 0; j < 4; ++j) {
                            const float xa = __builtin_fmaf(acc[ai][0][m][n][j], Ar, __builtin_fmaf(c1v[0][n][j], Br, c2v[0][n][j])), xb = __builtin_fmaf(acc[ai][1][m][n][j], Ar, __builtin_fmaf(c1v[1][n][j], Br, c2v[1][n][j]));
                            const float ea = 1.0f + fexp2(fminf(xa, 80.f)), eb = 1.0f + fexp2(fminf(xb, 80.f)); gb[4 * n + j] = frcp(eb); rt[4 * n + j] = eb * frcp(ea); }
                    u32x4 wr_, wg_; wr_.x = pk2(rt[0], rt[1]); wr_.y = pk2(rt[2], rt[3]); wr_.z = pk2(rt[4], rt[5]); wr_.w = pk2(rt[6], rt[7]);
                    wg_.x = pk2(gb[0], gb[1]); wg_.y = pk2(gb[2], gb[3]); wg_.z = pk2(gb[4], gb[5]); wg_.w = pk2(gb[6], gb[7]);
                    const unsigned o = doff0 + (unsigned)(ai * 8 + m) * dstep;
                    stg<u32x4>(dst, o, wr_); stg<u32x4>(dstb, o, wg_);
                }
            return;
        }
#pragma unroll
        for (int bj = 0; bj < 2; ++bj) {
            pg8::f32x4 c1v[2], c2v[2], lbv[2];
#pragma unroll
            for (int n = 0; n < 2; ++n) { c1v[n] = *(const LAS pg8::f32x4*)(sm + 2048 + (cl + bj * 128 + 4 * n) * 4); c2v[n] = *(const LAS pg8::f32x4*)(sm + 3072 + (cl + bj * 128 + 4 * n) * 4);
                lbv[n] = (type == 1) ? *(const LAS pg8::f32x4*)(sm + 4096 + (cl + bj * 128 + 4 * n) * 4) : (pg8::f32x4){0.f, 0.f, 0.f, 0.f}; }
            asm volatile("" ::: "memory");
#pragma unroll
            for (int ai = 0; ai < 2; ++ai) {
                pg8::f32x4 cs[4], sn[4];
                if (type == 3 || type == 4) {
#pragma unroll
                    for (int m = 0; m < 4; ++m) { cs[m] = ldg<pg8::f32x4>(cost, roff0 + (unsigned)((ai * 128 + m * 16) * 256)); sn[m] = ldg<pg8::f32x4>(sint, roff0 + (unsigned)((ai * 128 + m * 16) * 256)); }
                    asm volatile("" ::: "memory");
                }
#pragma unroll
                for (int m = 0; m < 4; ++m) {
                    const float Ar = A[ai * 4 + m], Br = B[ai * 4 + m];
                    pg8::f32x4 v[2];
#pragma unroll
                    for (int n = 0; n < 2; ++n)
#pragma unroll
                        for (int j = 0; j < 4; ++j) v[n][j] = __builtin_fmaf(acc[ai][bj][m][n][j], Ar, __builtin_fmaf(c1v[n][j], Br, c2v[n][j]));
                    if (type == 0) {
#pragma unroll
                        for (int n = 0; n < 2; ++n)
#pragma unroll
                            for (int j = 0; j < 4; ++j) v[n][j] = v[n][j] * frcp(1.0f + fexp2(v[n][j] * -LOG2E));
                    } else if (type == 1) {
#pragma unroll
                        for (int n = 0; n < 2; ++n)
#pragma unroll
                            for (int j = 0; j < 4; ++j) { const float lbx = lbv[n][j]; const float f = __builtin_fmaf(1.0f - lbx, frcp(1.0f + fexp2(v[n][j] * -LOG2E)), lbx); v[n][j] = __builtin_amdgcn_logf(fmaxf(f, 1e-30f)); }
                    } else if (type == 3 || type == 4) {
                        const float sc = type == 3 ? QSCALE : 1.0f;
                        const pg8::f32x4 x1 = v[0], x2 = v[1]; v[0] = (x1 * cs[m] - x2 * sn[m]) * sc; v[1] = (x2 * cs[m] + x1 * sn[m]) * sc;
                    }
                    u32x4 w; w.x = pk2(v[0][0], v[0][1]); w.y = pk2(v[0][2], v[0][3]); w.z = pk2(v[1][0], v[1][1]); w.w = pk2(v[1][2], v[1][3]);
                    stg<u32x4>(dst, doff0 + (unsigned)(ai * 8 + m) * dstep + bj * 256, w);
                }
            }
        }
    }
};

struct EpiMergeF {
    static constexpr bool PERM = true, HAS_MID = true, F16 = false;
    const bf16* ratio; const bf16* gateb; bf16* merged;
    __device__ __forceinline__ void mid(AccRef acc, const pg8::Unit& u, int wr, int wc, int fr, int fq) const {
        const int row0 = u.pm * 256 + wr * 64 + fr, col0 = u.pn * 256 + wc * 32 + 8 * fq;
        const unsigned off0 = (unsigned)((row0 * DM + col0) * 2);
#pragma unroll
        for (int ai = 0; ai < 2; ++ai) {
            u32x4 gv[4][2];
#pragma unroll
            for (int m = 0; m < 4; ++m)
#pragma unroll
                for (int bj = 0; bj < 2; ++bj) gv[m][bj] = ldg<u32x4>(ratio, off0 + (unsigned)((ai * 128 + m * 16) * DM * 2) + bj * 256);
            asm volatile("" ::: "memory");
#pragma unroll
            for (int m = 0; m < 4; ++m)
#pragma unroll
                for (int bj = 0; bj < 2; ++bj)
#pragma unroll
                    for (int j = 0; j < 8; ++j) { const unsigned gw_ = gv[m][bj][j >> 1]; const float gg = (j & 1) ? __uint_as_float(gw_ & 0xffff0000u) : __uint_as_float(gw_ << 16); acc[ai][bj][m][j >> 2][j & 3] *= gg; }
        }
    }
    __device__ __forceinline__ void prefetch(LAS unsigned char*, const pg8::Unit&, int, int) const {}
    __device__ __forceinline__ void operator()(AccRef acc, const pg8::Unit& u, int wr, int wc, int fr, int fq, const LAS unsigned char*) const {
        const int row0 = u.pm * 256 + wr * 64 + fr, col0 = u.pn * 256 + wc * 32 + 8 * fq;
        const unsigned off0 = (unsigned)((row0 * DM + col0) * 2);
#pragma unroll
        for (int ai = 0; ai < 2; ++ai) {
            u32x4 gv[4][2];
#pragma unroll
            for (int m = 0; m < 4; ++m)
#pragma unroll
                for (int bj = 0; bj < 2; ++bj) gv[m][bj] = ldg<u32x4>(gateb, off0 + (unsigned)((ai * 128 + m * 16) * DM * 2) + bj * 256);
            asm volatile("" ::: "memory");
#pragma unroll
            for (int m = 0; m < 4; ++m)
#pragma unroll
                for (int bj = 0; bj < 2; ++bj) { float r[8];
#pragma unroll
                    for (int j = 0; j < 8; ++j) { const unsigned gw_ = gv[m][bj][j >> 1]; const float gg = (j & 1) ? __uint_as_float(gw_ & 0xffff0000u) : __uint_as_float(gw_ << 16); r[j] = gg * acc[ai][bj][m][j >> 2][j & 3]; }
                    u32x4 w; w.x = pk2(r[0], r[1]); w.y = pk2(r[2], r[3]); w.z = pk2(r[4], r[5]); w.w = pk2(r[6], r[7]);
                    stg<u32x4>(merged, off0 + (unsigned)((ai * 128 + m * 16) * DM * 2) + bj * 256, w); }
        }
    }
};

template <int SRC> struct EpiResid {
    static constexpr bool PERM = true, HAS_MID = false, F16 = false;
    const float* srcp; const float* srcs; const unsigned short* y16src;
    const float* stats_in; const float* g; const float* b; unsigned short* y16dst; bf16* ybfdst; float* y32dst; float* stats_out;
    __device__ __forceinline__ void prefetch(LAS unsigned char* sm, const pg8::Unit& u, int wid, int lane) const {
        prefetch_stats(stats_in, u.pm, sm, wid, lane);
        if (wid == 1) { pg8::dma16(g, (unsigned)(u.pn * 1024 + lane * 16), sm + 2048); pg8::dma16(b, (unsigned)(u.pn * 1024 + lane * 16), sm + 3072); }
    }
    __device__ __forceinline__ void operator()(AccRef acc, const pg8::Unit& u, int wr, int wc, int fr, int fq, const LAS unsigned char* sm) const {
        const int row0 = u.pm * 256 + wr * 64 + fr, col0 = u.pn * 256 + wc * 32 + 8 * fq;
        const bool samp = u.pm >= 128;
        const float* src = samp ? srcs : srcp;
        const unsigned yoff0 = (unsigned)((row0 * DM + col0) * 2);
        const unsigned xoff0 = samp ? 2 * yoff0 - (unsigned)(NSEQ_P * SEQ_P) * DM * 4u : 2 * yoff0;
        float A[8], B[8]; lds_row_norms(sm, wr * 64 + fr, A, B);
        float ssum[8], ssq[8];
#pragma unroll
        for (int i = 0; i < 8; ++i) { ssum[i] = 0.f; ssq[i] = 0.f; }
        u32x4 raw[4], nraw[4];
        if (SRC != 0) {
#pragma unroll
            for (int m = 0; m < 4; ++m) raw[m] = ldg<u32x4>(y16src, yoff0 + (unsigned)((m * 16) * DM * 2));
        }
#pragma unroll
        for (int bj = 0; bj < 2; ++bj) {
            pg8::f32x4 gv[2], bv[2];
#pragma unroll
            for (int n = 0; n < 2; ++n) { gv[n] = *(const LAS pg8::f32x4*)(sm + 2048 + (wc * 32 + 8 * fq + bj * 128 + 4 * n) * 4) * ALPHA; bv[n] = *(const LAS pg8::f32x4*)(sm + 3072 + (wc * 32 + 8 * fq + bj * 128 + 4 * n) * 4) * ALPHA; }
#pragma unroll
            for (int ai = 0; ai < 2; ++ai) {
                pg8::f32x4 yv[4][2];
                if (SRC == 0) {
#pragma unroll
                    for (int m = 0; m < 4; ++m)
#pragma unroll
                        for (int n = 0; n < 2; ++n) yv[m][n] = ldg<pg8::f32x4>(src, xoff0 + (unsigned)((ai * 128 + m * 16) * DM * 4) + bj * 512 + 16 * n);
                } else {
                    if (bj * 2 + ai < 3) { const int nb_ = (bj * 2 + ai + 1) >> 1, na_ = (bj * 2 + ai + 1) & 1;
#pragma unroll
                        for (int m = 0; m < 4; ++m) nraw[m] = ldg<u32x4>(y16src, yoff0 + (unsigned)((na_ * 128 + m * 16) * DM * 2) + nb_ * 256); }
                }
                asm volatile("" ::: "memory");
#pragma unroll
                for (int m = 0; m < 4; ++m) {
                    const float Ar = A[ai * 4 + m], Br = B[ai * 4 + m]; const unsigned yoff = yoff0 + (unsigned)((ai * 128 + m * 16) * DM * 2) + bj * 256;
                    pg8::f32x4 o[2];
#pragma unroll
                    for (int n = 0; n < 2; ++n) {
                        const pg8::f32x4 yy = SRC == 0 ? yv[m][n] : (pg8::f32x4){h2f_lo(raw[m][2 * n]), h2f_hi(raw[m][2 * n]), h2f_lo(raw[m][2 * n + 1]), h2f_hi(raw[m][2 * n + 1])};
                        o[n] = ((yy * Ar + Br) * gv[n] + bv[n]) + acc[ai][bj][m][n];
                        ssum[ai * 4 + m] += (o[n][0] + o[n][1]) + (o[n][2] + o[n][3]); ssq[ai * 4 + m] += (o[n][0] * o[n][0] + o[n][1] * o[n][1]) + (o[n][2] * o[n][2] + o[n][3] * o[n][3]); }
                    if (y32dst) { stg<pg8::f32x4>(y32dst, 2 * yoff, o[0]); stg<pg8::f32x4>(y32dst, 2 * yoff + 16, o[1]); }
                    if (y16dst) { u32x4 w; w.x = pk2h(o[0][0], o[0][1]); w.y = pk2h(o[0][2], o[0][3]); w.z = pk2h(o[1][0], o[1][1]); w.w = pk2h(o[1][2], o[1][3]); stg<u32x4>(y16dst, yoff, w); }
                    if (ybfdst) { u32x4 w; w.x = pk2(o[0][0], o[0][1]); w.y = pk2(o[0][2], o[0][3]); w.z = pk2(o[1][0], o[1][1]); w.w = pk2(o[1][2], o[1][3]); stg<u32x4>(ybfdst, yoff, w); }
                }
                asm volatile("" ::: "memory");
                if (SRC != 0) {
#pragma unroll
                    for (int m = 0; m < 4; ++m) raw[m] = nraw[m]; }
            }
        }
        int fr2 = fr, fq2 = fq; asm volatile("" : "+v"(fr2), "+v"(fq2));
        const unsigned soff0 = (unsigned)((u.pm * 256 + wr * 64 + fr2) * 8 + 4 * fq2);
#pragma unroll
        for (int i = 0; i < 8; ++i) { float s = ssum[i], s2 = ssq[i];
            s += __shfl_xor(s, 16); s += __shfl_xor(s, 32); s2 += __shfl_xor(s2, 16); s2 += __shfl_xor(s2, 32);
            const int iv = (fq2 == 0) ? (int)rintf(s * STAT_Q1) : (int)rintf(s2 * STAT_Q2);
            if (fq2 < 2) __hip_atomic_fetch_add((GAS int*)((GAS char*)stats_out + soff0 + (unsigned)(((i >> 2) * 128 + (i & 3) * 16) * 8)), iv, __ATOMIC_RELAXED, __HIP_MEMORY_SCOPE_AGENT); }
    }
};

struct EpiSwiglu {
    static constexpr bool PERM = true, HAS_MID = false, F16 = false;
    const float* stats; const float* c1; const float* c2; bf16* hid;
    __device__ __forceinline__ void prefetch(LAS unsigned char* sm, const pg8::Unit& u, int wid, int lane) const {
        prefetch_stats(stats, u.pm, sm, wid, lane);
        if (wid == 1) { pg8::dma16(c1, (unsigned)(u.pn * 1024 + lane * 16), sm + 2048); pg8::dma16(c2, (unsigned)(u.pn * 1024 + lane * 16), sm + 3072); }
    }
    __device__ __forceinline__ void operator()(AccRef acc, const pg8::Unit& u, int wr, int wc, int fr, int fq, const LAS unsigned char* sm) const {
        const int row0 = u.pm * 256 + wr * 64 + fr, cl = wc * 32 + 8 * fq;
        float A[8], B[8]; lds_row_norms(sm, wr * 64 + fr, A, B);
        pg8::f32x4 c1v[2][2], c2v[2][2];
#pragma unroll
        for (int bj = 0; bj < 2; ++bj)
#pragma unroll
            for (int n = 0; n < 2; ++n) { c1v[bj][n] = *(const LAS pg8::f32x4*)(sm + 2048 + (cl + bj * 128 + 4 * n) * 4); c2v[bj][n] = *(const LAS pg8::f32x4*)(sm + 3072 + (cl + bj * 128 + 4 * n) * 4); }
        asm volatile("" ::: "memory");
        const unsigned hoff0 = (unsigned)((row0 * DFF + u.pn * 128 + cl) * 2);
#pragma unroll
        for (int ai = 0; ai < 2; ++ai)
#pragma unroll
            for (int m = 0; m < 4; ++m) {
                const float Ar = A[ai * 4 + m], Br = B[ai * 4 + m];
                float r[8];
#pragma unroll
                for (int n = 0; n < 2; ++n)
#pragma unroll
                    for (int j = 0; j < 4; ++j) { const float gt = __builtin_fmaf(acc[ai][0][m][n][j], Ar, __builtin_fmaf(c1v[0][n][j], Br, c2v[0][n][j])), up = __builtin_fmaf(acc[ai][1][m][n][j], Ar, __builtin_fmaf(c1v[1][n][j], Br, c2v[1][n][j]));
                        r[4 * n + j] = gt * up * frcp(1.0f + fexp2(gt * -LOG2E)); }
                u32x4 w; w.x = pk2(r[0], r[1]); w.y = pk2(r[2], r[3]); w.z = pk2(r[4], r[5]); w.w = pk2(r[6], r[7]);
                stg<u32x4>(hid, hoff0 + (unsigned)((ai * 128 + m * 16) * DFF * 2), w);
            }
    }
};

__device__ __forceinline__ unsigned off_b(unsigned row, unsigned ch) { return 256u * row + 16u * (ch ^ (((row & 3) << 2) | ((row >> 2) & 3))); }
__device__ __forceinline__ bf16x8 frag_row(const LAS unsigned char* img, int r0, int ks, int lane) { return *(const LAS bf16x8*)(img + off_b(r0 + (lane & 31), 2 * ks + (lane >> 5))); }
__device__ __forceinline__ bf16x8 frag_tr(const LAS unsigned char* img, int k0, int c0, int lane) {
    const unsigned h = lane >> 5, blk = (lane >> 4) & 1, q = (lane & 15) >> 2, p = lane & 3;
    const unsigned ch = (unsigned)(c0 >> 3) + 2 * blk + (p >> 1);
    const s16x4 lo = __builtin_amdgcn_ds_read_tr16_b64_v4i16((LAS s16x4*)(img + off_b(k0 + 8 * h + q, ch) + 8 * (p & 1)));
    const s16x4 hi = __builtin_amdgcn_ds_read_tr16_b64_v4i16((LAS s16x4*)(img + off_b(k0 + 8 * h + 4 + q, ch) + 8 * (p & 1)));
    return (bf16x8){lo[0], lo[1], lo[2], lo[3], hi[0], hi[1], hi[2], hi[3]};
}
__device__ __forceinline__ bf16x8 frag_tr_acc(const LAS unsigned char* img, int k0, int c0, int lane) {
    const unsigned h = lane >> 5, blk = (lane >> 4) & 1, q = (lane & 15) >> 2, p = lane & 3;
    const unsigned ch = (unsigned)(c0 >> 3) + 2 * blk + (p >> 1);
    const s16x4 lo = __builtin_amdgcn_ds_read_tr16_b64_v4i16((LAS s16x4*)(img + off_b(k0 + 4 * h + q, ch) + 8 * (p & 1)));
    const s16x4 hi = __builtin_amdgcn_ds_read_tr16_b64_v4i16((LAS s16x4*)(img + off_b(k0 + 8 + 4 * h + q, ch) + 8 * (p & 1)));
    return (bf16x8){lo[0], lo[1], lo[2], lo[3], hi[0], hi[1], hi[2], hi[3]};
}
__device__ __forceinline__ int crow(int r, int h) { return (r & 3) + 8 * (r >> 2) + 4 * h; }
#define MFMA32(A, B, C) __builtin_amdgcn_mfma_f32_32x32x16_bf16((A), (B), (C), 0, 0, 0)

constexpr int SC_RQ = 0, SC_RG = 16384, SC_VI = 32768, SC_SI = 49152, SC_QT = 81920, SC_KT = 100352, SC_AI = 118784, SC_EM = 128000, SC_EE = 128512, SC_EME = 129024, SC_END = 129536;
constexpr int T_STR = 144, AI_STR = 144;
static_assert(SC_END <= RING_BYTES, "scan LDS");
__device__ __forceinline__ bf16x8 frag_tr144(const LAS unsigned char* img, int k0, int c0, int lane) {
    const unsigned h = lane >> 5, blk = (lane >> 4) & 1, q = (lane & 15) >> 2, p = lane & 3;
    const LAS unsigned char* ad = img + (k0 + 8 * h + q) * T_STR + (c0 + 16 * blk + 4 * p) * 2;
    const s16x4 lo = __builtin_amdgcn_ds_read_tr16_b64_v4i16((LAS s16x4*)ad);
    const s16x4 hi = __builtin_amdgcn_ds_read_tr16_b64_v4i16((LAS s16x4*)(ad + 4 * T_STR));
    return (bf16x8){lo[0], lo[1], lo[2], lo[3], hi[0], hi[1], hi[2], hi[3]};
}
constexpr int SC_BEL = 129536;
static_assert(SC_BEL + 512 <= RING_BYTES, "scan LDS");
template <int MODE>
__device__ __forceinline__ void scan_unit(const Args& a, LAS unsigned char* lds, int rowbase, int head, int dir, int seg, int tid, int wave, int lane) {
    constexpr int L = SEQ_P; constexpr int mode = MODE;
    const unsigned char* hq = a.ws + P_HQ; const unsigned char* gg = a.ws + (dir ? P_GB : P_GF); const unsigned char* hv = a.ws + P_HI;
    unsigned char* oraw = a.ws + (dir ? WS_OBWD : WS_AOUT);
    LAS unsigned char* RQ = lds + SC_RQ; LAS unsigned char* RG = lds + SC_RG; LAS unsigned char* VI = lds + SC_VI; LAS unsigned char* SI = lds + SC_SI;
    LAS unsigned char* QT = lds + SC_QT; LAS unsigned char* KT = lds + SC_KT; LAS unsigned char* AI = lds + SC_AI;
    LAS float* em = (LAS float*)(lds + SC_EM); LAS float* ee = (LAS float*)(lds + SC_EE); LAS float* eme = (LAS float*)(lds + SC_EME); LAS float* bel = (LAS float*)(lds + SC_BEL);
    const int h = lane >> 5, l31 = lane & 31, blk = (lane >> 4) & 1, q4 = (lane & 15) >> 2, p = lane & 3;
    const int tb = wave >> 2, kb = wave & 3;
    constexpr bool passA = MODE == 1;
    bf16x8 Ld[2], Lone;
#pragma unroll
    for (int ksl = 0; ksl < 2; ++ksl)
#pragma unroll
        for (int j = 0; j < 8; ++j) Ld[ksl][j] = (16 * ksl + 8 * h + j <= l31) ? (short)0x3F80 : (short)0;
#pragma unroll
    for (int j = 0; j < 8; ++j) Lone[j] = (short)0x3F80;
    const int kk0 = 32 * ((2 * wave) & 3) + l31, kk1 = 32 * ((2 * wave + 1) & 3) + l31;
    f32x16 S0, S1;
#pragma unroll
    for (int r = 0; r < 16; ++r) { S0[r] = 0.f; S1[r] = 0.f; }
    float dlog0 = 0.f, dlog1 = 0.f;
    if (mode == 2) {
        const int nprev = dir ? (3 - seg) : seg;
        for (int i = 0; i < nprev; ++i) { const int sg = dir ? (3 - i) : i; const int slot = (sg * 8 + head) * 2 + dir;
            const float* E = (const float*)(a.ws + WS_SEGE) + ((size_t)slot * 512 + tid) * 32; const float* D = (const float*)(a.ws + WS_SEGD) + slot * 128;
            const float d0 = fexp2(D[kk0]), d1 = fexp2(D[kk1]);
#pragma unroll
            for (int r4 = 0; r4 < 4; ++r4) { const f32x4 e0 = *(const f32x4*)(E + 4 * r4), e1 = *(const f32x4*)(E + 16 + 4 * r4);
#pragma unroll
                for (int j = 0; j < 4; ++j) { S0[4 * r4 + j] = S0[4 * r4 + j] * d0 + e0[j]; S1[4 * r4 + j] = S1[4 * r4 + j] * d1 + e1[j]; } } }
    }
    constexpr int nch = L / 64;
    u32x4 pq[2], pg[2], pv[2];
    const unsigned colb = (unsigned)((head * 128 + (tid & 15) * 8) * 2);
    auto chunk_off = [&](int cc, int e) -> unsigned { const int c0 = dir ? (L - 64 * (cc + 1)) : 64 * cc; const int i = (tid >> 4) + 32 * e; const int t = dir ? (c0 + 63 - i) : (c0 + i);
        return (unsigned)(rowbase + t) * (unsigned)(HW * 2) + colb; };
#pragma unroll
    for (int e = 0; e < 2; ++e) { const unsigned o = chunk_off(0, e); pq[e] = passA ? (u32x4){0u, 0u, 0u, 0u} : ldg<u32x4>(hq, o); pg[e] = ldg<u32x4>(gg, o); pv[e] = ldg<u32x4>(hv, o); }
    for (int cc = 0; cc < nch; ++cc) {
        const int c0 = dir ? (L - 64 * (cc + 1)) : 64 * cc;
#pragma unroll
        for (int e = 0; e < 2; ++e) { const unsigned ob = off_b((tid >> 4) + 32 * e, tid & 15); *(LAS u32x4*)(RQ + ob) = pq[e]; *(LAS u32x4*)(RG + ob) = pg[e]; *(LAS u32x4*)(VI + ob) = pv[e]; }
        if (cc + 1 < nch) {
#pragma unroll
            for (int e = 0; e < 2; ++e) { const unsigned o = chunk_off(cc + 1, e); if (!passA) pq[e] = ldg<u32x4>(hq, o); pg[e] = ldg<u32x4>(gg, o); pv[e] = ldg<u32x4>(hv, o); }
        }
        __syncthreads();
        { s16x4 graw[4], qraw[4];
#pragma unroll
          for (int g4 = 0; g4 < 4; ++g4) { const unsigned ad = off_b(32 * tb + 8 * g4 + 4 * h + q4, 4 * kb + 2 * blk + (p >> 1)) + 8 * (p & 1);
              graw[g4] = __builtin_amdgcn_ds_read_tr16_b64_v4i16((LAS s16x4*)(RG + ad)); qraw[g4] = __builtin_amdgcn_ds_read_tr16_b64_v4i16((LAS s16x4*)(RQ + ad)); }
          f32x16 c;
#pragma unroll
          for (int r = 0; r < 16; ++r) c[r] = 0.f;
          float bmid, bend = 0.f;
          if (tb == 0) { c = MFMA32(Ld[0], frag_tr(RG, 0, 32 * kb, lane), c); c = MFMA32(Ld[1], frag_tr(RG, 16, 32 * kb, lane), c); bmid = __shfl(c[15], l31 + 32); }
          else { c = MFMA32(Lone, frag_tr(RG, 0, 32 * kb, lane), c); c = MFMA32(Lone, frag_tr(RG, 16, 32 * kb, lane), c); bmid = c[0];
                 c = MFMA32(Ld[0], frag_tr(RG, 32, 32 * kb, lane), c); c = MFMA32(Ld[1], frag_tr(RG, 48, 32 * kb, lane), c); bend = __shfl(c[15], l31 + 32); }
          const int kk = 32 * kb + l31;
#pragma unroll
          for (int g4 = 0; g4 < 4; ++g4) { float qs[4], ks[4];
#pragma unroll
              for (int j = 0; j < 4; ++j) { const float gv = bf2f((unsigned short)graw[g4][j]), qv = bf2f((unsigned short)qraw[g4][j]); const float x = c[4 * g4 + j] - bmid;
                  qs[j] = qv * fexp2(fminf(x, 100.f)); ks[j] = (1.0f - fexp2(gv)) * fexp2(fminf(-x, 100.f)); }
              const unsigned ad = (unsigned)(kk * T_STR + (32 * tb + 8 * g4 + 4 * h) * 2);
              u32x2 wq, wk; wq.x = pk2(qs[0], qs[1]); wq.y = pk2(qs[2], qs[3]); wk.x = pk2(ks[0], ks[1]); wk.y = pk2(ks[2], ks[3]);
              *(LAS u32x2*)(QT + ad) = wq; *(LAS u32x2*)(KT + ad) = wk; }
          if (tb == 1 && h == 0) { em[kk] = fexp2(bmid); ee[kk] = fexp2(bend); eme[kk] = fexp2(bend - bmid); bel[kk] = bend; } }
        __syncthreads();
        if (!passA) {
#pragma unroll
        for (int e = 0; e < 2; ++e) { const int id = 2 * wave + e, vb2 = id >> 2, kk = e ? kk1 : kk0; const float emk = em[kk];
#pragma unroll
            for (int g4 = 0; g4 < 4; ++g4) { const f32x16& S = e ? S1 : S0; u32x2 w; w.x = pk2(S[4 * g4] * emk, S[4 * g4 + 1] * emk); w.y = pk2(S[4 * g4 + 2] * emk, S[4 * g4 + 3] * emk);
                *(LAS u32x2*)(SI + off_b(kk, 4 * vb2 + g4) + 8 * h) = w; } }
        if (wave < 3) { const int sb = wave == 2 ? 1 : 0, tbm = wave == 0 ? 0 : 1; f32x16 c;
#pragma unroll
            for (int r = 0; r < 16; ++r) c[r] = 0.f;
            { bf16x8 ka = frag_tr144(KT, 0, 32 * sb, lane), qa = frag_tr144(QT, 0, 32 * tbm, lane);
#pragma unroll
              for (int ks = 0; ks < 8; ++ks) { bf16x8 kn = ka, qn = qa;
                  if (ks < 7) { kn = frag_tr144(KT, 16 * (ks + 1), 32 * sb, lane); qn = frag_tr144(QT, 16 * (ks + 1), 32 * tbm, lane); }
                  c = MFMA32(ka, qa, c); ka = kn; qa = qn; } }
            const int t = 32 * tbm + l31;
#pragma unroll
            for (int g4 = 0; g4 < 4; ++g4) { float x[4];
#pragma unroll
                for (int j = 0; j < 4; ++j) { const int sx = 32 * sb + 8 * g4 + 4 * h + j; x[j] = (sx <= t) ? c[4 * g4 + j] : 0.f; }
                u32x2 w; w.x = pk2(x[0], x[1]); w.y = pk2(x[2], x[3]); *(LAS u32x2*)(AI + t * AI_STR + (32 * sb + 8 * g4 + 4 * h) * 2) = w; } }
        }
#pragma unroll
        for (int e = 0; e < 2; ++e) { const int id = 2 * wave + e, vb2 = id >> 2, kk = e ? kk1 : kk0; f32x16 c;
#pragma unroll
            for (int r = 0; r < 16; ++r) c[r] = 0.f;
#pragma unroll
            for (int ks = 0; ks < 4; ++ks) c = MFMA32(frag_tr(VI, 16 * ks, 32 * vb2, lane), *(const LAS bf16x8*)(KT + kk * T_STR + (16 * ks + 8 * h) * 2), c);
            const float eek = ee[kk], emek = eme[kk];
            if (e) { dlog1 += bel[kk];
#pragma unroll
                for (int r = 0; r < 16; ++r) S1[r] = S1[r] * eek + c[r] * emek; }
            else { dlog0 += bel[kk];
#pragma unroll
                for (int r = 0; r < 16; ++r) S0[r] = S0[r] * eek + c[r] * emek; } }
        __syncthreads();
        if (!passA) { const int vb = kb; f32x16 c;
#pragma unroll
          for (int r = 0; r < 16; ++r) c[r] = 0.f;
          const LAS unsigned char* aip = AI + (32 * tb + l31) * AI_STR + 16 * h;
          { bf16x8 xa = frag_tr144(QT, 0, 32 * tb, lane), xb = frag_tr(SI, 0, 32 * vb, lane);
#pragma unroll
            for (int ks = 0; ks < 8; ++ks) { bf16x8 na, nb;
                if (ks < 7) { na = frag_tr144(QT, 16 * (ks + 1), 32 * tb, lane); nb = frag_tr(SI, 16 * (ks + 1), 32 * vb, lane); }
                else { na = *(const LAS bf16x8*)aip; nb = frag_tr(VI, 0, 32 * vb, lane); }
                c = MFMA32(xa, xb, c); xa = na; xb = nb; }
            { bf16x8 na = *(const LAS bf16x8*)(aip + 32), nb = frag_tr(VI, 16, 32 * vb, lane); c = MFMA32(xa, xb, c); xa = na; xb = nb; }
            if (tb) { bf16x8 na = *(const LAS bf16x8*)(aip + 64), nb = frag_tr(VI, 32, 32 * vb, lane); c = MFMA32(xa, xb, c); xa = na; xb = nb;
                      na = *(const LAS bf16x8*)(aip + 96); nb = frag_tr(VI, 48, 32 * vb, lane); c = MFMA32(xa, xb, c); xa = na; xb = nb; }
            c = MFMA32(xa, xb, c); }
          const unsigned lo = (unsigned)((head * 128 + 32 * vb + l31) * 2) + (unsigned)((dir ? 4 - 4 * h : 4 * h) * (HW * 2));
          const int tu0 = __builtin_amdgcn_readfirstlane(rowbase + (dir ? c0 + 63 - 32 * tb - 4 : c0 + 32 * tb));
#pragma unroll
          for (int r = 0; r < 16; r += 2) { const unsigned w = pk2(c[r], c[r + 1]);
              const int d0 = (r & 3) + 8 * (r >> 2), d1 = d0 + 1;
              unsigned char* b0 = oraw + (size_t)(unsigned)(dir ? tu0 - d0 : tu0 + d0) * (size_t)(HW * 2); unsigned char* b1 = oraw + (size_t)(unsigned)(dir ? tu0 - d1 : tu0 + d1) * (size_t)(HW * 2);
              stg<unsigned short>(b0, lo, (unsigned short)(w & 0xffffu)); stg<unsigned short>(b1, lo, (unsigned short)(w >> 16)); }
          __syncthreads(); }
    }
    if (passA) {
        const int slot = (seg * 8 + head) * 2 + dir;
        float* E = (float*)(a.ws + WS_SEGE) + ((size_t)slot * 512 + tid) * 32; float* D = (float*)(a.ws + WS_SEGD) + slot * 128;
#pragma unroll
        for (int r4 = 0; r4 < 4; ++r4) { *(f32x4*)(E + 4 * r4) = (f32x4){S0[4 * r4], S0[4 * r4 + 1], S0[4 * r4 + 2], S0[4 * r4 + 3]}; *(f32x4*)(E + 16 + 4 * r4) = (f32x4){S1[4 * r4], S1[4 * r4 + 1], S1[4 * r4 + 2], S1[4 * r4 + 3]}; }
        if (wave < 2 && h == 0) { D[kk0] = dlog0; D[kk1] = dlog1; }
    }
}

__device__ __forceinline__ void finalize_a(const Args& a, int l, int gw, int ngw, int lane, int m_lo, int m_hi) {
    bf16* of = (bf16*)(a.ws + WS_AOUT); const bf16* ob = (const bf16*)(a.ws + WS_OBWD); const bf16* hg = (const bf16*)(a.ws + P_HG);
    const float* ng = a.hg_norm_g + l * 128;
    const int c8 = (lane & 15) * 8;
    float gv[8];
#pragma unroll
    for (int j = 0; j < 8; ++j) gv[j] = ng[c8 + j];
    const unsigned lo = (unsigned)(((lane >> 4) * 128 + c8) * 2);
    struct Rows { u32x4 f[2], b[2], g[2]; };
    auto load = [&](Rows& R, int m) {
#pragma unroll
        for (int p = 0; p < 2; ++p) { const unsigned o = (unsigned)m * (unsigned)(HW * 2) + lo + (unsigned)(p * 1024); R.f[p] = ldg<u32x4>(of, o); R.b[p] = ldg<u32x4>(ob, o); R.g[p] = ldg<u32x4>(hg, o); } };
    auto finish = [&](const Rows& R, int m) {
#pragma unroll
        for (int p = 0; p < 2; ++p) {
            float x[8], ss = 0.f;
#pragma unroll
            for (int j = 0; j < 8; ++j) { const unsigned fw = R.f[p][j >> 1], bw = R.b[p][j >> 1]; const float fv = (j & 1) ? __uint_as_float(fw & 0xffff0000u) : __uint_as_float(fw << 16);
                const float bv = (j & 1) ? __uint_as_float(bw & 0xffff0000u) : __uint_as_float(bw << 16); x[j] = fv + bv; ss += x[j] * x[j]; }
            ss += __shfl_xor(ss, 1); ss += __shfl_xor(ss, 2); ss += __shfl_xor(ss, 4); ss += __shfl_xor(ss, 8);
            const float rs = 1.0f / sqrtf(ss * (1.0f / 128.0f) + RMS_EPS);
            float r[8];
#pragma unroll
            for (int j = 0; j < 8; ++j) { const unsigned gw_ = R.g[p][j >> 1]; const float gt = (j & 1) ? __uint_as_float(gw_ & 0xffff0000u) : __uint_as_float(gw_ << 16); r[j] = x[j] * rs * gv[j] * gt; }
            u32x4 w; w.x = pk2(r[0], r[1]); w.y = pk2(r[2], r[3]); w.z = pk2(r[4], r[5]); w.w = pk2(r[6], r[7]);
            stg<u32x4>(of, (unsigned)m * (unsigned)(HW * 2) + lo + (unsigned)(p * 1024), w); } };
    Rows A, B;
    int m = m_lo + gw;
    if (m < m_hi) load(A, m);
    for (; m < m_hi; m += 2 * ngw) {
        const bool hb = m + ngw < m_hi;
        if (hb) load(B, m + ngw);
        asm volatile("" ::: "memory");
        finish(A, m);
        if (!hb) break;
        if (m + 2 * ngw < m_hi) load(A, m + 2 * ngw);
        asm volatile("" ::: "memory");
        finish(B, m + ngw);
    }
}

constexpr int AT_K = 0, AT_V = 32768, AT_BUF = 65536;
static_assert(2 * AT_BUF <= RING_BYTES, "attention LDS");
__device__ __forceinline__ void attn_unit(const Args& a, int l, LAS unsigned char* lds, int unit, int tid, int wave, int lane) {
    const int nb = unit >> 2, hk = (unit >> 1) & 1, hh = unit & 1;
    int n, N; if (nb < 256) { n = nb & 15; N = 16; } else { n = nb - 256; N = 64; }
    const int qhead = 4 * hk + 2 * hh + (wave >> 2), qt = wave & 3, h = lane >> 5, l31 = lane & 31;
    const bf16* aq = (const bf16*)(a.ws + P_AQ); const unsigned char* ak = a.ws + P_AK; const unsigned char* av = a.ws + P_AV; unsigned char* bo = a.ws + WS_BOUT;
    const int qi = 32 * qt + l31;
    const size_t qrow = (size_t)nb * 128 + qi;
    const int kb_lo = n > 0 ? n - 1 : 0, kb_hi = n + 1 < N ? n + 1 : N - 1;
    auto stage = [&](int kb, int b) {
        const unsigned rowoff = (unsigned)((nb + (kb - n)) * 128) * (unsigned)(KVW * 2) + (unsigned)(hk * 256);
#pragma unroll
        for (int e = 0; e < 4; ++e) { const unsigned row = (unsigned)(e * 32 + (tid >> 4)), ch = (unsigned)(tid & 15) ^ (((row & 3) << 2) | ((row >> 2) & 3));
            const unsigned go = rowoff + row * (unsigned)(KVW * 2) + ch * 16u;
            __builtin_amdgcn_global_load_lds((const GAS unsigned*)((const GAS unsigned char*)ak + go), (LAS unsigned*)(lds + b * AT_BUF + AT_K + e * 8192 + wave * 1024), 16, 0, 0);
            __builtin_amdgcn_global_load_lds((const GAS unsigned*)((const GAS unsigned char*)av + go), (LAS unsigned*)(lds + b * AT_BUF + AT_V + e * 8192 + wave * 1024), 16, 0, 0); } };
    __syncthreads();
    stage(kb_lo, 0);
    bf16x8 qf[8];
#pragma unroll
    for (int ks = 0; ks < 8; ++ks) qf[ks] = *(const bf16x8*)(aq + qrow * HW + qhead * 128 + 16 * ks + 8 * h);
    f32x16 O[4];
#pragma unroll
    for (int c = 0; c < 4; ++c)
#pragma unroll
        for (int r = 0; r < 16; ++r) O[c][r] = 0.f;
    float mrun = a.attn_sink[l * 8 + qhead] * LOG2E, lrun = 1.0f;
    int b = 0;
    for (int kb = kb_lo; kb <= kb_hi; ++kb, b ^= 1) {
        asm volatile("s_waitcnt vmcnt(0)" ::: "memory");
        __syncthreads();
        if (kb < kb_hi) stage(kb + 1, b ^ 1);
        const LAS unsigned char* KI = lds + b * AT_BUF + AT_K; const LAS unsigned char* VI = lds + b * AT_BUF + AT_V;
        const int rel = kb - n;
        for (int kt = 0; kt < 4; ++kt) {
            if ((rel < 0 && kt < qt) || (rel > 0 && kt > qt)) continue;
            f32x16 s;
#pragma unroll
            for (int r = 0; r < 16; ++r) s[r] = 0.f;
#pragma unroll
            for (int ks = 0; ks < 8; ++ks) s = MFMA32(frag_row(KI, 32 * kt, ks, lane), qf[ks], s);
            if (rel != 0 && kt == qt) {
#pragma unroll
                for (int r = 0; r < 16; ++r) { const int jj = 32 * kt + crow(r, h); const bool ok = rel < 0 ? (jj >= qi) : (jj <= qi); s[r] = ok ? s[r] : -__builtin_inff(); } }
            float mx = s[0];
#pragma unroll
            for (int r = 1; r < 16; ++r) mx = fmaxf(mx, s[r]);
            mx = fmaxf(mx, __shfl_xor(mx, 32));
            const float mnew = fmaxf(mrun, mx), alpha = fexp2(mrun - mnew); mrun = mnew;
            float ps = 0.f;
#pragma unroll
            for (int r = 0; r < 16; ++r) { s[r] = fexp2(s[r] - mnew); ps += s[r]; }
            ps += __shfl_xor(ps, 32);
            lrun = lrun * alpha + ps;
            bf16x8 pf[2];
#pragma unroll
            for (int sx = 0; sx < 2; ++sx) { u32x4 w; w.x = pk2(s[8 * sx], s[8 * sx + 1]); w.y = pk2(s[8 * sx + 2], s[8 * sx + 3]); w.z = pk2(s[8 * sx + 4], s[8 * sx + 5]); w.w = pk2(s[8 * sx + 6], s[8 * sx + 7]);
                pf[sx] = __builtin_bit_cast(bf16x8, w); }
            if (__builtin_amdgcn_ballot_w64(alpha != 1.0f) != 0ull) {
#pragma unroll
                for (int c = 0; c < 4; ++c)
#pragma unroll
                    for (int r = 0; r < 16; ++r) O[c][r] *= alpha; }
#pragma unroll
            for (int c = 0; c < 4; ++c)
#pragma unroll
                for (int sx = 0; sx < 2; ++sx) O[c] = MFMA32(frag_tr_acc(VI, 32 * kt + 16 * sx, 32 * c, lane), pf[sx], O[c]);
        }
    }
    const float inv = 1.0f / lrun;
    const unsigned oo = (unsigned)(((unsigned)qrow * HW + qhead * 128 + 4 * h) * 2);
#pragma unroll
    for (int c = 0; c < 4; ++c)
#pragma unroll
        for (int g4 = 0; g4 < 4; ++g4) { u32x2 w; w.x = pk2(O[c][4 * g4] * inv, O[c][4 * g4 + 1] * inv); w.y = pk2(O[c][4 * g4 + 2] * inv, O[c][4 * g4 + 3] * inv);
            stg<u32x2>(bo, oo + (unsigned)((32 * c + 8 * g4) * 2), w); }
}


__device__ __forceinline__ void final_ln(const Args& a, int gw, int ngw, int lane) {
    const float* st = (const float*)(a.ws + WS_STATS + 8 * STATS_BYTES); const float* g = a.ln2_g + 3 * DM; const float* b = a.ln2_b + 3 * DM;
    for (int m = gw; m < MTOK; m += ngw) { float A, B; row_norm(st, m, A, B);
        f32x4* yr = (f32x4*)(a.out + (size_t)m * DM) + lane;
#pragma unroll
        for (int j = 0; j < 8; ++j) { const f32x4 v = yr[64 * j], gv = *((const f32x4*)g + lane + 64 * j), bv = *((const f32x4*)b + lane + 64 * j); yr[64 * j] = (v * A + B) * gv + bv; } }
}

constexpr int N_PHASES = 1 + 8 * DEPTH + 1;
constexpr int FIN_EARLY = 10 * SEQ_P;
#ifndef PH_MASK
#define PH_MASK 0xfff
#endif
#define PHON(j) (((PH_MASK) >> (j)) & 1)
__global__ void __launch_bounds__(NTHREADS, 2) enc_fwd(Args a0) {
    extern __shared__ __attribute__((aligned(16))) unsigned char lds_raw[];
    LAS unsigned char* lds = (LAS unsigned char*)lds_raw;
    volatile LAS unsigned* MISC = (volatile LAS unsigned*)(lds + MISC_OFF);
    const int tid0 = threadIdx.x, wave = __builtin_amdgcn_readfirstlane(tid0 >> 6);
    const int G = gridDim.x, bx = blockIdx.x;
    const int vcu = (G % 8 == 0) ? (bx % 8) * (G / 8) + bx / 8 : bx;
    const int gw = vcu * NWAVES + wave, ngw = G * NWAVES;
    for (int u = tid0; u < (LDS_BYTES - MISC_OFF) / 4; u += NTHREADS) ((LAS unsigned*)(lds + MISC_OFF))[u] = 0u;
    __syncthreads();
    XcdBarrier bar; bar.bar = (unsigned*)(a0.ws + WS_CTL); bar.x = 0; bar.st = nullptr;
#if !MK_PER_PHASE_LAUNCH
    bar = xcd_barrier_post((unsigned*)(a0.ws + WS_CTL), MISC + 8, tid0 == 0);
#endif
    const int lo = a0.ph_lo, hi = a0.ph_hi;
#define IN(k) (lo <= (k) && (k) < hi)
#define LAUNDER() int tid = wave * 64 + lane_id(); asm volatile("" : "+v"(tid)); const int lane = tid & 63; Args a = a0; asm volatile("" : "+s"(a.ws), "+s"(a.out))
#if MK_PER_PHASE_LAUNCH
#define SEAM(k) do { } while (0)
#else
#define SEAM(k) do { if ((k) + 1 < hi) xcd_barrier(bar, wave == 0 && lane_id() == 0); } while (0)
#endif
    if (PHON(8) && IN(0)) { LAUNDER(); prologue(a, gw, ngw, lane); SEAM(0); }

#ifndef PROBE_MIX
#define PROBE_MIX 0
#endif
#if PROBE_MIX
    for (int it_ = 0; it_ < 2 * DEPTH; ++it_) {
        int it = it_; asm volatile("" : "+s"(it)); int l = it >> 1; const int sub = it & 1;
#else
    for (int l_ = 0; l_ < DEPTH; ++l_) {
        int l = l_; asm volatile("" : "+s"(l));
        constexpr int sub = -1;
#endif
        const bool do_scan = sub != 1 || PROBE_MIX != 3, do_attn = sub != 1 || PROBE_MIX != 2, do_fin = sub != 1 || PROBE_MIX != 3;
        const int pb = 1 + 8 * l;
#define LOCALS() LAUNDER(); unsigned char* wsw = a.ws + WS_W; float* cv = (float*)(a.ws + WS_CVEC + (size_t)l * CVEC_LAYER); \
        const float* stats_in = (const float*)(a.ws + WS_STATS + (size_t)(l == 0 ? 0 : 2 * l) * STATS_BYTES); \
        float* stats_1 = (float*)(a.ws + WS_STATS + (size_t)(1 + 2 * l) * STATS_BYTES); float* stats_2 = (float*)(a.ws + WS_STATS + (size_t)(2 + 2 * l) * STATS_BYTES); \
        bf16* ybf = (bf16*)(a.ws + WS_YBF); (void)wsw; (void)cv; (void)stats_in; (void)stats_1; (void)stats_2; (void)ybf
        if (sub != 1 && PHON(0) && IN(pb + 0)) { LOCALS(); convert_layer(a, l, lds, gw, ngw, wave, lane); SEAM(pb + 0); }
        if (sub != 1 && PHON(1) && IN(pb + 1)) { LOCALS();
            pg8::Gemm g{ybf, nullptr, (const bf16*)(wsw + W_IN), MTOK, NPROJ, DM, DM}; pg8::StaticOrder S; S.init(MTOK, NPROJ, G, bx);
            EpiProj E{a.ws, stats_in, cv, cv + NPROJ, (const float*)(a.ws + WS_LB) + l * 2048};
            pg8::gemm_phase<EpiProj, pg8::StaticOrder>(lds, g, S, E, wave);
            SEAM(pb + 1);
        }
        if (PHON(2) && IN(pb + 2)) { LOCALS();
            if (do_scan) for (int u = bx; u < 256; u += G) {
                if (u < 48) { const int hd = u & 7, dir = (u >> 3) & 1, seg = (u >> 4) + dir; scan_unit<1>(a, lds, NSEQ_P * SEQ_P + seg * SEQ_P, hd, dir, seg, tid, wave, lane); }
                else { const int v = u - 48; scan_unit<0>(a, lds, (v >> 4) * SEQ_P, (v >> 1) & 7, v & 1, 0, tid, wave, lane); }
            }
            if (do_attn && G == 256) { const int an0 = bx < 48 ? 3 : 1, a00 = bx < 48 ? 3 * bx : 144 + (bx - 48); for (int j = 0; j < an0; ++j) attn_unit(a, l, lds, a00 + j, tid, wave, lane); }
            __syncthreads();
            xcd_barrier(bar, wave == 0 && lane_id() == 0);
            if (do_scan) for (int u = bx; u < 112; u += G) {
                if (u < 48) { const int v = 208 + u; scan_unit<0>(a, lds, (v >> 4) * SEQ_P, (v >> 1) & 7, v & 1, 0, tid, wave, lane); }
                else { const int v = u - 48, seg = v >> 4; scan_unit<2>(a, lds, NSEQ_P * SEQ_P + seg * SEQ_P, (v >> 1) & 7, v & 1, seg, tid, wave, lane); }
            }
            { int a0 = bx, astr = G, an = (1280 - bx + G - 1) / G, aex = -1;
              if (G == 256) { astr = 1; if (bx < 112) { a0 = 352 + 2 * bx; an = 2; } else { const int w = bx - 112; a0 = 576 + (w < 128 ? 5 * w : 640 + 4 * (w - 128)); an = w < 128 ? 5 : 4; } }
              if (do_attn) for (int j = 0; j < an + (aex >= 0 ? 1 : 0); ++j) attn_unit(a, l, lds, j < an ? a0 + j * astr : aex, tid, wave, lane);
              if (do_fin && G == 256 && bx >= 112) finalize_a(a, l, (bx - 112) * NWAVES + wave, 144 * NWAVES, lane, 0, FIN_EARLY); }
            __syncthreads();
            SEAM(pb + 2);
        }
        if (sub != 0 && PHON(3) && IN(pb + 3)) { LOCALS(); finalize_a(a, l, gw, ngw, lane, G == 256 ? FIN_EARLY : 0, MTOK); SEAM(pb + 3); }
        if (sub != 0 && PHON(4) && IN(pb + 4)) { LOCALS();
            pg8::Gemm g{(const bf16*)(a.ws + WS_AOUT), (const bf16*)(a.ws + WS_BOUT), (const bf16*)(wsw + W_A), MTOK, DM, DM, HW}; pg8::StaticOrder S; S.init(MTOK, DM, G, bx);
            EpiMergeF E{(const bf16*)(a.ws + P_GA), (const bf16*)(a.ws + P_GBB), (bf16*)(a.ws + WS_MERGED)};
            pg8::gemm_phase<EpiMergeF, pg8::StaticOrder>(lds, g, S, E, wave);
            SEAM(pb + 4);
        }
        if (sub != 0 && PHON(5) && IN(pb + 5)) { LOCALS();
            pg8::Gemm g{(const bf16*)(a.ws + WS_MERGED), nullptr, (const bf16*)(wsw + W_OUT), MTOK, DM, DM, DM}; pg8::StaticOrder S; S.init(MTOK, DM, G, bx);
            const float* gi = l == 0 ? a.ln_in_g : a.ln2_g + (size_t)(l - 1) * DM; const float* bi = l == 0 ? a.ln_in_b : a.ln2_b + (size_t)(l - 1) * DM;
            if (l == 0) { EpiResid<0> E{a.xp, a.xs, nullptr, stats_in, gi, bi, (unsigned short*)(a.ws + P_GA), (bf16*)(a.ws + P_GBB), nullptr, stats_1};
                pg8::gemm_phase<EpiResid<0>, pg8::StaticOrder>(lds, g, S, E, wave); }
            else { EpiResid<1> E{nullptr, nullptr, (const unsigned short*)a.out, stats_in, gi, bi, (unsigned short*)(a.ws + P_GA), (bf16*)(a.ws + P_GBB), nullptr, stats_1};
                pg8::gemm_phase<EpiResid<1>, pg8::StaticOrder>(lds, g, S, E, wave); }
            SEAM(pb + 5);
        }
        if (sub != 0 && PHON(6) && IN(pb + 6)) { LOCALS();
            pg8::Gemm g{(const bf16*)(a.ws + P_GBB), nullptr, (const bf16*)(wsw + W_FIN), MTOK, NFFN, DM, DM}; pg8::StaticOrder S; S.init(MTOK, NFFN, G, bx);
            EpiSwiglu E{stats_1, cv + 2 * NPROJ, cv + 2 * NPROJ + NFFN, (bf16*)(a.ws + WS_HID)};
            pg8::gemm_phase<EpiSwiglu, pg8::StaticOrder>(lds, g, S, E, wave);
            SEAM(pb + 6);
        }
        if (sub != 0 && PHON(7) && IN(pb + 7)) { LOCALS();
            pg8::Gemm g{(const bf16*)(a.ws + WS_HID), nullptr, (const bf16*)(wsw + W_FOUT), MTOK, DM, DFF, DFF}; pg8::StaticOrder S; S.init(MTOK, DM, G, bx);
            EpiResid<1> E{nullptr, nullptr, (const unsigned short*)(a.ws + P_GA), stats_1, a.ln1_g + (size_t)l * DM, a.ln1_b + (size_t)l * DM,
                          l == DEPTH - 1 ? nullptr : (unsigned short*)a.out, l == DEPTH - 1 ? nullptr : ybf, l == DEPTH - 1 ? a.out : nullptr, stats_2};
            pg8::gemm_phase<EpiResid<1>, pg8::StaticOrder>(lds, g, S, E, wave);
            SEAM(pb + 7);
        }
    }
    if (PHON(9) && IN(N_PHASES - 1)) { LAUNDER(); final_ln(a, gw, ngw, lane); }
#undef IN
#undef SEAM
#undef LAUNDER
#undef LOCALS
}

extern "C" void kernel_launch(void* const* d_in, const int* in_sizes, int n_in, void* d_out, int out_size, void* d_ws, size_t ws_size, hipStream_t stream) {
    static int grid = 0;
    if (grid == 0) {
        if (n_in != 17 || out_size != MTOK * DM || ws_size < WS_END) { fprintf(stderr, "kernel_launch: unexpected shapes (n_in %d out %d ws %zu need %zu)\n", n_in, out_size, ws_size, (size_t)WS_END); grid = -1; return; }
        int dev = 0, cus = 0, per_cu = 0;
        if (hipGetDevice(&dev) != hipSuccess || hipDeviceGetAttribute(&cus, hipDeviceAttributeMultiprocessorCount, dev) != hipSuccess) { grid = -1; return; }
        if (hipFuncSetAttribute((const void*)enc_fwd, hipFuncAttributeMaxDynamicSharedMemorySize, LDS_BYTES) != hipSuccess) { fprintf(stderr, "kernel_launch: hipFuncSetAttribute failed\n"); grid = -1; return; }
        if (hipOccupancyMaxActiveBlocksPerMultiprocessor(&per_cu, (const void*)enc_fwd, NTHREADS, LDS_BYTES) != hipSuccess || per_cu < 1) { fprintf(stderr, "kernel_launch: occupancy query says %d\n", per_cu); }
        (void)hipGetLastError();
        grid = cus;
    }
    if (grid < 0) return;
    (void)hipMemsetAsync((char*)d_ws, 0, ZERO_BYTES, stream);
    Args a{};
    a.xp = (const float*)d_in[0]; a.xs = (const float*)d_in[1]; a.ln_in_g = (const float*)d_in[2]; a.ln_in_b = (const float*)d_in[3]; a.w_in = (const float*)d_in[4];
    a.lb_logits = (const float*)d_in[5]; a.hg_norm_g = (const float*)d_in[6]; a.attn_sink = (const float*)d_in[7]; a.w_a = (const float*)d_in[8]; a.w_b = (const float*)d_in[9];
    a.w_out = (const float*)d_in[10]; a.ln1_g = (const float*)d_in[11]; a.ln1_b = (const float*)d_in[12]; a.w_ffn_in = (const float*)d_in[13]; a.w_ffn_out = (const float*)d_in[14];
    a.ln2_g = (const float*)d_in[15]; a.ln2_b = (const float*)d_in[16]; a.out = (float*)d_out; a.ws = (unsigned char*)d_ws;
#if MK_PER_PHASE_LAUNCH
    for (int p = 0; p < N_PHASES; ++p) { a.ph_lo = p; a.ph_hi = p + 1; hipLaunchKernelGGL(enc_fwd, dim3(grid), dim3(NTHREADS), LDS_BYTES, stream, a); }
#else
    a.ph_lo = 0; a.ph_hi = N_PHASES;
    hipLaunchKernelGGL(enc_fwd, dim3(grid), dim3(NTHREADS), LDS_BYTES, stream, a);
#endif
}
```

```cpp
#include <hip/hip_runtime.h>
#include <cstdio>
#include <cstdint>

#ifndef MK_PER_PHASE_LAUNCH
#define MK_PER_PHASE_LAUNCH 0
#endif

namespace pg8 {
#define PG8_LAS __attribute__((address_space(3)))
typedef unsigned short bf16_t;
typedef short bf16x8 __attribute__((ext_vector_type(8)));
typedef _Float16 f16x8 __attribute__((ext_vector_type(8)));
typedef float f32x4 __attribute__((ext_vector_type(4)));
typedef unsigned u32x4 __attribute__((ext_vector_type(4)));
typedef unsigned u32x2 __attribute__((ext_vector_type(2)));
constexpr int BM = 256, BK = 64, HALF = 128, HTB = HALF * BK * 2, STAGE_BYTES = 8 * HTB, NXCD = 8, WGM = 4;
constexpr int SM_OFF = STAGE_BYTES + 1024, SM_HALF = 6144;
__device__ __forceinline__ void dma16(const void* gbase, unsigned goff, PG8_LAS unsigned char* dst) {
    __builtin_amdgcn_global_load_lds((const __attribute__((address_space(1))) unsigned*)((const __attribute__((address_space(1))) unsigned char*)gbase + goff), (PG8_LAS unsigned*)dst, 16, 0, 0); }

__host__ __device__ __forceinline__ int lds_byte(int r, int c) { const int st = (r >> 4) * 2 + (c >> 5), rr = r & 15, cc = c & 31, ob = rr * 64 + cc * 2; return st * 1024 + (ob ^ (((ob >> 9) & 1) << 5)); }
__host__ __device__ __forceinline__ void stage_rc(int b, int& R, int& C) { const int st = b / 1024, sb = b % 1024, swz = sb ^ (((sb >> 9) & 1) << 5); R = (st >> 1) * 16 + swz / 64; C = (st & 1) * 32 + (swz % 64) / 2; }
__host__ __device__ __forceinline__ int perm32(int rho) { const int n = rho >> 4, i = rho & 15; return 8 * (i >> 2) + 4 * n + (i & 3); }

struct Unit { int pm, pn; };
struct Gemm { const bf16_t* A; const bf16_t* A2; const bf16_t* Bt; int M, N, K, lda; };

struct StaticOrder {
    int nM, nN, nwg, G, c;
    __host__ __device__ void init(int M, int N, int G_, int c_) { nM = M / BM; nN = N / BM; nwg = nM * nN; G = G_; c = c_; }
    __host__ __device__ bool next(int i, Unit& u) const {
        const long L = (long)i * G + c; if (L >= nwg) return false;
        int wgid = (int)L; { const int q = nwg / NXCD, r = nwg % NXCD, xcd = wgid % NXCD, off = wgid / NXCD; wgid = (xcd < r ? xcd * (q + 1) : r * (q + 1) + (xcd - r) * q) + off; }
        const int nig = WGM * nN, gid = wgid / nig, fm = gid * WGM, gsz = (nM - fm) < WGM ? (nM - fm) : WGM;
        u.pm = fm + ((wgid % nig) % gsz); u.pn = (wgid % nig) / gsz; return true;
    }
    __device__ __forceinline__ void a_ready(const Unit&) const {}
    __device__ __forceinline__ void done(const Unit&) const {}
};

__device__ __forceinline__ unsigned cvt_pk_bf16(float lo, float hi) { unsigned r; asm volatile("v_cvt_pk_bf16_f32 %0, %1, %2" : "=v"(r) : "v"(lo), "v"(hi)); return r; }
__device__ __forceinline__ unsigned cvt_pk_f16(float lo, float hi) { unsigned r; asm volatile("v_cvt_pk_f16_f32 %0, %1, %2" : "=v"(r) : "v"(lo), "v"(hi)); return r; }

#ifndef GP_ALIGN
#define GP_ALIGN true
#endif
#ifndef GP_SP2
#define GP_SP2 true
#endif
template <class Epi, class Sched, bool ALIGN_EPI = GP_ALIGN, bool SP2 = GP_SP2>
__device__ __forceinline__ void gemm_phase(PG8_LAS unsigned char* lds, const Gemm g_, const Sched& S, const Epi& E, int wid_) {
    int tid_; asm volatile("v_mbcnt_lo_u32_b32 %0, -1, 0\n\tv_mbcnt_hi_u32_b32 %0, -1, %0" : "=v"(tid_)); tid_ += wid_ * 64;
    Gemm g = g_; asm volatile("" : "+s"(g.A), "+s"(g.A2), "+s"(g.Bt));
    const int tid = tid_, wid = __builtin_amdgcn_readfirstlane(tid >> 6), lane = tid & 63, wr = wid >> 2, wc = wid & 3, fr = lane & 15, fq = lane >> 4;
    const int K = g.K, nt = K / BK;
    unsigned voffA[2], voffB[2];
#define PG8_VOFF(tidv) do { _Pragma("unroll") for (int i = 0; i < 2; ++i) { int R, C; stage_rc((tidv) * 16 + i * 8192, R, C); const int Rb = Epi::PERM ? ((R & ~31) + perm32(R & 31)) : R; \
        voffA[i] = (unsigned)(R * g.lda + C) * 2u; voffB[i] = (unsigned)(Rb * K + C) * 2u; } } while (0)
    PG8_VOFF(tid);
    constexpr unsigned kstep = BK * 2;
    const unsigned hstep = (unsigned)(HALF * K * 2), hstepA = (unsigned)(HALF * g.lda * 2);
    const unsigned tstep = 2 * hstep, tstepA = 2 * hstepA;
    const bool dualA = g.A2 != nullptr; const int ntA = dualA ? nt / 2 : nt; const int a2delta = dualA ? (int)(((const char*)g.A2 - (const char*)g.A) - (ptrdiff_t)ntA * (ptrdiff_t)kstep) : 0;
    const unsigned ldsw = (unsigned)wid * 1024u;
    const int aoff = lds_byte(wr * 64 + fr, fq * 8), boff = lds_byte(wc * 32 + fr, fq * 8);
#define PG8_SA(b, h) (((b) * 2 + (h)) * HTB)
#define PG8_SB(b, h) ((4 + (b) * 2 + (h)) * HTB)
#define PG8_STAGE(bufoff, gbase, voff) do { _Pragma("unroll") for (int _i = 0; _i < 2; ++_i) \
        __builtin_amdgcn_global_load_lds((const unsigned*)((const char*)(gbase) + (voff)[_i]), (PG8_LAS unsigned*)(lds + (bufoff) + ldsw + _i * 8192), 16, 0, 0); } while (0)
#define PG8_LDA(dst, b, h) do { _Pragma("unroll") for (int m = 0; m < 4; ++m) _Pragma("unroll") for (int k = 0; k < 2; ++k) dst[m][k] = *(const PG8_LAS bf16x8*)(lds + PG8_SA(b, h) + aoff + m * 2048 + k * 1024); } while (0)
#define PG8_LDB(dst, b, h) do { _Pragma("unroll") for (int n = 0; n < 2; ++n) _Pragma("unroll") for (int k = 0; k < 2; ++k) dst[n][k] = *(const PG8_LAS bf16x8*)(lds + PG8_SB(b, h) + boff + n * 2048 + k * 1024); } while (0)
#define PG8_MMA(ai, bj, At, Bt) do { __builtin_amdgcn_s_setprio(1); _Pragma("unroll") for (int m = 0; m < 4; ++m) _Pragma("unroll") for (int n = 0; n < 2; ++n) _Pragma("unroll") for (int k = 0; k < 2; ++k) { \
        if constexpr (Epi::F16) acc[ai][bj][m][n] = __builtin_amdgcn_mfma_f32_16x16x32_f16(__builtin_bit_cast(f16x8, Bt[n][k]), __builtin_bit_cast(f16x8, At[m][k]), acc[ai][bj][m][n], 0, 0, 0); \
        else acc[ai][bj][m][n] = __builtin_amdgcn_mfma_f32_16x16x32_bf16(Bt[n][k], At[m][k], acc[ai][bj][m][n], 0, 0, 0); } __builtin_amdgcn_s_setprio(0); } while (0)
#define PG8_WAIT_V(n) asm volatile("s_waitcnt vmcnt(" #n ")" ::: "memory")
#define PG8_WAIT_L(n) asm volatile("s_waitcnt lgkmcnt(" #n ")" ::: "memory")
#define PG8_BAR __builtin_amdgcn_s_barrier()
#define PG8_SCHED __builtin_amdgcn_sched_barrier(0)
    Unit cur, nxt; int ui = 0;
    if (!S.next(0, cur)) return;
    f32x4 acc[2][2][4][2];
#pragma unroll
    for (int a = 0; a < 2; ++a)
#pragma unroll
        for (int b = 0; b < 2; ++b)
#pragma unroll
            for (int m = 0; m < 4; ++m)
#pragma unroll
                for (int n = 0; n < 2; ++n) acc[a][b][m][n] = (f32x4){0.f, 0.f, 0.f, 0.f};
    bf16x8 At[4][2], B0[2][2], B1[2][2];
    const char* cA = (const char*)g.A + (size_t)cur.pm * tstepA; const char* cB = (const char*)g.Bt + (size_t)cur.pn * tstep;
    PG8_LAS unsigned char* smb = lds + SM_OFF;
    E.prefetch(smb, cur, wid, lane);
    S.a_ready(cur);
    if constexpr (SP2) {
        PG8_STAGE(PG8_SB(0, 0), cB, voffB); PG8_STAGE(PG8_SB(0, 1), cB + hstep, voffB); PG8_STAGE(PG8_SA(0, 0), cA, voffA); PG8_STAGE(PG8_SA(0, 1), cA + hstepA, voffA);
        if (wr == 1) PG8_BAR;
        PG8_WAIT_V(2); PG8_BAR;
        PG8_STAGE(PG8_SB(1, 0), cB + kstep, voffB); PG8_STAGE(PG8_SA(1, 0), cA + kstep, voffA); PG8_STAGE(PG8_SB(1, 1), cB + hstep + kstep, voffB);
        PG8_WAIT_V(6); PG8_BAR;
    } else {
        PG8_STAGE(PG8_SB(0, 0), cB, voffB); PG8_STAGE(PG8_SA(0, 0), cA, voffA); PG8_STAGE(PG8_SB(0, 1), cB + hstep, voffB); PG8_STAGE(PG8_SA(0, 1), cA + hstepA, voffA);
        if (wr == 1) PG8_BAR;
        PG8_WAIT_V(4); PG8_BAR;
        PG8_STAGE(PG8_SB(1, 0), cB + kstep, voffB); PG8_STAGE(PG8_SA(1, 0), cA + kstep, voffA); PG8_STAGE(PG8_SB(1, 1), cB + hstep + kstep, voffB);
        PG8_WAIT_V(6); PG8_BAR;
    }
    for (;;) {
        const bool has_next = S.next(ui + 1, nxt);
        const char* nA = has_next ? (const char*)g.A + (size_t)nxt.pm * tstepA : cA; const char* nB = has_next ? (const char*)g.Bt + (size_t)nxt.pn * tstep : cB;
        for (int t = 0; t < nt; t += 2) {
            const bool last = (t == nt - 2);
            const char* a1 = cA + (ptrdiff_t)((t >= ntA ? a2delta : 0) + (int)((t + 1) * kstep));
            const char* a2 = last ? nA : cA + (ptrdiff_t)((t + 2 >= ntA ? a2delta : 0) + (int)((t + 2) * kstep)); const char* b2 = last ? nB : cB + (size_t)((t + 2) * kstep);
            const char* a3 = a2 + kstep; const char* b3 = b2 + kstep;
            if (last && has_next) S.a_ready(nxt);
            if constexpr (Epi::HAS_MID) { if (t == ntA) { int fr_ = fr, fq_ = fq; asm volatile("" : "+v"(fr_), "+v"(fq_)); E.mid(acc, cur, wr, wc, fr_, fq_); } }
            if constexpr (SP2) {
            PG8_LDB(B0, 0, 0); PG8_LDB(B1, 0, 1); PG8_SCHED; PG8_LDA(At, 0, 0); PG8_STAGE(PG8_SA(1, 1), a1 + hstepA, voffA);
            PG8_WAIT_V(8); PG8_WAIT_L(0); PG8_BAR; PG8_MMA(0, 0, At, B0); PG8_MMA(0, 1, At, B1); PG8_BAR; PG8_SCHED;
            PG8_LDA(At, 0, 1); PG8_STAGE(PG8_SB(0, 0), b2, voffB); PG8_STAGE(PG8_SB(0, 1), b2 + hstep, voffB); PG8_STAGE(PG8_SA(0, 0), a2, voffA);
            PG8_WAIT_V(8); PG8_WAIT_L(0); PG8_BAR; PG8_MMA(1, 0, At, B0); PG8_MMA(1, 1, At, B1); PG8_BAR; PG8_SCHED;
            PG8_LDB(B0, 1, 0); PG8_LDB(B1, 1, 1); PG8_SCHED; PG8_LDA(At, 1, 0); PG8_STAGE(PG8_SA(0, 1), a2 + hstepA, voffA);
            PG8_WAIT_V(8); PG8_WAIT_L(0); PG8_BAR; PG8_MMA(0, 0, At, B0); PG8_MMA(0, 1, At, B1); PG8_BAR; PG8_SCHED;
            PG8_LDA(At, 1, 1); PG8_STAGE(PG8_SB(1, 0), b3, voffB); PG8_STAGE(PG8_SB(1, 1), b3 + hstep, voffB); PG8_STAGE(PG8_SA(1, 0), a3, voffA);
            PG8_WAIT_V(8); PG8_WAIT_L(0); PG8_BAR; PG8_MMA(1, 0, At, B0); PG8_MMA(1, 1, At, B1); PG8_BAR; PG8_SCHED;
            } else {
            PG8_LDB(B0, 0, 0); PG8_SCHED; PG8_LDA(At, 0, 0); PG8_STAGE(PG8_SA(1, 1), a1 + hstepA, voffA);
            PG8_WAIT_L(8); PG8_BAR; PG8_WAIT_L(0); PG8_MMA(0, 0, At, B0); PG8_BAR; PG8_SCHED;
            PG8_LDB(B1, 0, 1); PG8_STAGE(PG8_SB(0, 0), b2, voffB);
            PG8_BAR; PG8_WAIT_L(0); PG8_MMA(0, 1, At, B1); PG8_BAR;
            PG8_LDA(At, 0, 1); PG8_STAGE(PG8_SA(0, 0), a2, voffA);
            PG8_BAR; PG8_WAIT_L(0); PG8_MMA(1, 0, At, B0); PG8_BAR; PG8_SCHED;
            PG8_STAGE(PG8_SB(0, 1), b2 + hstep, voffB);
            PG8_WAIT_V(6); PG8_BAR; PG8_MMA(1, 1, At, B1); PG8_BAR;
            PG8_LDB(B0, 1, 0); PG8_SCHED; PG8_LDA(At, 1, 0); PG8_STAGE(PG8_SA(0, 1), a2 + hstepA, voffA);
            PG8_WAIT_L(8); PG8_BAR; PG8_WAIT_L(0); PG8_MMA(0, 0, At, B0); PG8_BAR; PG8_SCHED;
            PG8_LDB(B1, 1, 1); PG8_STAGE(PG8_SB(1, 0), b3, voffB);
            PG8_BAR; PG8_WAIT_L(0); PG8_MMA(0, 1, At, B1); PG8_BAR;
            PG8_LDA(At, 1, 1); PG8_STAGE(PG8_SA(1, 0), a3, voffA);
            PG8_BAR; PG8_WAIT_L(0); PG8_MMA(1, 0, At, B0); PG8_BAR; PG8_SCHED;
            PG8_STAGE(PG8_SB(1, 1), b3 + hstep, voffB);
            PG8_WAIT_V(6); PG8_BAR; PG8_MMA(1, 1, At, B1); PG8_BAR;
            }
        }
        if constexpr (ALIGN_EPI) { if (wr == 0) PG8_BAR; }
        { int fr_ = fr, fq_ = fq; asm volatile("" : "+v"(fr_), "+v"(fq_));
          E(acc, cur, wr, wc, fr_, fq_, smb + (ui & 1) * SM_HALF); }
        if (!has_next) break;
        { int l2; asm volatile("v_mbcnt_lo_u32_b32 %0, -1, 0\n\tv_mbcnt_hi_u32_b32 %0, -1, %0" : "=v"(l2)); E.prefetch(smb + ((ui + 1) & 1) * SM_HALF, nxt, wid, l2); }
        { int tid2; asm volatile("v_mbcnt_lo_u32_b32 %0, -1, 0\n\tv_mbcnt_hi_u32_b32 %0, -1, %0" : "=v"(tid2)); tid2 += wid_ * 64; PG8_VOFF(tid2); }
#pragma unroll
        for (int a = 0; a < 2; ++a)
#pragma unroll
            for (int b = 0; b < 2; ++b)
#pragma unroll
                for (int m = 0; m < 4; ++m)
#pragma unroll
                    for (int n = 0; n < 2; ++n) acc[a][b][m][n] = (f32x4){0.f, 0.f, 0.f, 0.f};
        cur = nxt; cA = nA; cB = nB; ++ui;
        if constexpr (ALIGN_EPI) { if (wr == 1) PG8_BAR; }
    }
    PG8_WAIT_V(0);
    if constexpr (!ALIGN_EPI) { if (wr == 0) PG8_BAR; }
    PG8_BAR;
#undef PG8_VOFF
#undef PG8_SA
#undef PG8_SB
#undef PG8_STAGE
#undef PG8_LDA
#undef PG8_LDB
#undef PG8_MMA
#undef PG8_WAIT_V
#undef PG8_WAIT_L
#undef PG8_BAR
#undef PG8_SCHED
}
}

constexpr int NWAVES = 8, NTHREADS = NWAVES * 64;
constexpr int DM = 2048, DEPTH = 4, NPROJ = 10752, DFF = 5632, NFFN = 2 * DFF;
constexpr int SEQ_P = 2048, NSEQ_P = 16, SEQ_S = 8192;
constexpr int MTOK = NSEQ_P * SEQ_P + SEQ_S;
constexpr int HW = 1024;
constexpr int KVW = 256;
constexpr float LN_EPS = 1e-5f, RMS_EPS = 1e-6f;
constexpr float ALPHA = 1.6817928305074292f;
constexpr float LOG2E = 1.4426950408889634f;
constexpr float QSCALE = 0.08838834764831845f * 1.4426950408889634f;

constexpr size_t MiB = 1u << 20;
constexpr size_t WS_CTL = 0;
constexpr size_t WS_STATS = 64 * 1024;
constexpr size_t STATS_BYTES = (size_t)MTOK * 8;
constexpr size_t WS_CVEC = WS_STATS + 9 * STATS_BYTES;
constexpr size_t CVEC_LAYER = (size_t)(2 * NPROJ + 2 * NFFN) * 4;
constexpr size_t ZERO_BYTES = 4 * MiB;
static_assert(WS_CVEC + DEPTH * CVEC_LAYER <= ZERO_BYTES, "zeroed region");
constexpr size_t WS_LB = 4 * MiB;
constexpr size_t WS_COS = 5 * MiB, WS_SIN = 7 * MiB;
constexpr size_t WS_SEGE = 9 * MiB;
constexpr size_t WS_SEGD = 13 * MiB;
constexpr size_t WS_W = 14 * MiB;
constexpr size_t W_IN = 0, W_A = W_IN + (size_t)NPROJ * DM * 2, W_B = W_A + (size_t)DM * HW * 2, W_OUT = W_B + (size_t)DM * HW * 2,
                 W_FIN = W_OUT + (size_t)DM * DM * 2, W_FOUT = W_FIN + (size_t)NFFN * DM * 2, W_END = W_FOUT + (size_t)DM * DFF * 2;
static_assert(W_END == 124 * MiB, "weights per layer");
constexpr size_t WS_YBF = WS_W + 124 * MiB;
static_assert(WS_SEGE + 64 * 512 * 32 * 4 <= WS_SEGD && WS_SEGD + 64 * 128 * 4 <= WS_W, "segment state buffers");
constexpr size_t WS_PROJ = WS_YBF + 160 * MiB;
constexpr size_t SZ1K = (size_t)MTOK * HW * 2;
constexpr size_t P_HQ = WS_PROJ, P_GF = P_HQ + SZ1K, P_GB = P_GF + SZ1K, P_HI = P_GB + SZ1K, P_HG = P_HI + SZ1K, P_AQ = P_HG + SZ1K,
                 P_AK = P_AQ + SZ1K, P_AV = P_AK + SZ1K / 4, P_GA = P_AV + SZ1K / 4, P_GBB = P_GA + 2 * SZ1K, P_END = P_GBB + 2 * SZ1K;
constexpr size_t WS_MERGED = P_HQ;
constexpr size_t WS_HID = P_HQ;
static_assert((size_t)MTOK * DFF * 2 <= P_END - P_HQ, "hidden overlay");
constexpr size_t WS_AOUT = P_END, WS_BOUT = WS_AOUT + SZ1K, WS_OBWD = WS_BOUT + SZ1K, WS_END = WS_OBWD + SZ1K;
static_assert(WS_END <= 1408 * MiB, "workspace");

constexpr int RING_BYTES = 131072;
constexpr int MISC_OFF = RING_BYTES;
constexpr int LDS_BYTES = 147456;

#define GAS __attribute__((address_space(1)))
#define LAS __attribute__((address_space(3)))
typedef unsigned short bf16;
typedef float f32x4 __attribute__((ext_vector_type(4)));
typedef float f32x16 __attribute__((ext_vector_type(16)));
typedef short bf16x8 __attribute__((ext_vector_type(8)));
typedef short s16x4 __attribute__((ext_vector_type(4)));
typedef unsigned u32x4 __attribute__((ext_vector_type(4)));
typedef unsigned u32x2 __attribute__((ext_vector_type(2)));
typedef float f32x2 __attribute__((ext_vector_type(2)));
typedef int i32x2 __attribute__((ext_vector_type(2)));
constexpr float STAT_Q1 = 8192.f, STAT_S1 = 1.0f / 8192.f, STAT_Q2 = 512.f, STAT_S2 = 1.0f / 512.f;

__device__ __forceinline__ float bf2f(unsigned short b) { return __uint_as_float(((unsigned)b) << 16); }
__device__ __forceinline__ unsigned f2bf(float f) { unsigned u = __float_as_uint(f); return (u + 0x7fffu + ((u >> 16) & 1u)) >> 16; }
__device__ __forceinline__ unsigned pk2(float lo, float hi) { return pg8::cvt_pk_bf16(lo, hi); }
__device__ __forceinline__ unsigned pk2h(float lo, float hi) { return pg8::cvt_pk_f16(lo, hi); }
typedef _Float16 f16x2 __attribute__((ext_vector_type(2)));
__device__ __forceinline__ float h2f_lo(unsigned u) { return (float)__builtin_bit_cast(f16x2, u)[0]; }
__device__ __forceinline__ float h2f_hi(unsigned u) { return (float)__builtin_bit_cast(f16x2, u)[1]; }
__device__ __forceinline__ float fexp2(float x) { return __builtin_amdgcn_exp2f(x); }
__device__ __forceinline__ float frcp(float x) { return __builtin_amdgcn_rcpf(x); }
template <int FRAC> __device__ __forceinline__ float qfix(float v) { return __builtin_rintf(v * (float)(1 << FRAC)) * (1.0f / (float)(1 << FRAC)); }
__device__ __forceinline__ float sigmoidf_(float x) { return frcp(1.0f + fexp2(-x * LOG2E)); }
__device__ __forceinline__ float siluf_(float x) { return x * sigmoidf_(x); }

__device__ __forceinline__ int lane_id() { int l; asm volatile("v_mbcnt_lo_u32_b32 %0, -1, 0\n\tv_mbcnt_hi_u32_b32 %0, -1, %0" : "=v"(l)); return l; }

#define XB_TMO      128
#define XB_XCNT(j)  (256  + 64 * (j))
#define XB_XSUB(j)  (1280 + 64 * (j))
#define XB_XGEN(j)  (2304 + 64 * (j))
#define XB_TOP      3328
#define XB_TOPGEN   3392
#define XCD_BAR_WORDS 3456
#define XB_SPIN_CAP (1u << 24)
__device__ __forceinline__ unsigned xb_ld(unsigned* p)              { return __hip_atomic_load(p, __ATOMIC_RELAXED, __HIP_MEMORY_SCOPE_AGENT); }
__device__ __forceinline__ unsigned xb_add(unsigned* p, unsigned v) { return __hip_atomic_fetch_add(p, v, __ATOMIC_RELAXED, __HIP_MEMORY_SCOPE_AGENT); }
__device__ __forceinline__ unsigned xb_xcc_id() { return (unsigned)__builtin_amdgcn_s_getreg((3 << 11) | 20) & 0xFu; }
#define XB_SPIN(cond, bar) do { unsigned _sp = 0; while (cond) { __builtin_amdgcn_s_sleep(1); \
    if ((++_sp & 255u) == 0u) { if (xb_ld(&(bar)[XB_TMO])) break; if (_sp > XB_SPIN_CAP) { atomicAdd(&(bar)[XB_TMO], 1u); break; } } } } while (0)
struct XcdBarrier { unsigned* bar; unsigned x; volatile LAS unsigned* st; };
__device__ __forceinline__ XcdBarrier xcd_barrier_post(unsigned* bar, volatile LAS unsigned* st, bool leader) {
    XcdBarrier b; b.bar = bar; b.x = xb_xcc_id(); b.st = st;
    if (leader) (void)xb_add(&bar[XB_XCNT(b.x)], 1u);
    return b;
}
__device__ __forceinline__ void xcd_barrier_complete(unsigned* bar, unsigned x, unsigned& nloc, unsigned& nx) {
    const unsigned G = gridDim.x * gridDim.y * gridDim.z;
    unsigned sum, cnt, mine, sp = 0u;
    for (;;) {
        sum = 0u; cnt = 0u; mine = 0u;
#pragma unroll
        for (unsigned j = 0; j < 16; ++j) { const unsigned c = xb_ld(&bar[XB_XCNT(j)]); sum += c; cnt += (c > 0u) ? 1u : 0u; mine = (j == x) ? c : mine; }
        if (sum == G) break;
        __builtin_amdgcn_s_sleep(1);
        if ((++sp & 255u) == 0u) { if (xb_ld(&bar[XB_TMO])) break; if (sp > XB_SPIN_CAP) { atomicAdd(&bar[XB_TMO], 1u); break; } }
    }
    nloc = mine > 0u ? mine : 1u; nx = cnt > 0u ? cnt : 1u;
}
__device__ __forceinline__ void xcd_barrier(const XcdBarrier& b, bool leader) {
    asm volatile("s_waitcnt vmcnt(0)" ::: "memory");
    __syncthreads();
    if (leader) {
        unsigned* bar = b.bar;
        __builtin_amdgcn_s_waitcnt(0);
        unsigned nloc = b.st[0], nx = b.st[1];
        if (nloc == 0u) { xcd_barrier_complete(bar, b.x, nloc, nx); b.st[0] = nloc; b.st[1] = nx; }
        const unsigned old = xb_add(&bar[XB_XSUB(b.x)], 1u);
        const unsigned gen = old / nloc;
        if (old + 1u == (gen + 1u) * nloc) {
            __builtin_amdgcn_fence(__ATOMIC_RELEASE, "agent");
            asm volatile("s_waitcnt vmcnt(0)" ::: "memory");
            const unsigned og = xb_add(&bar[XB_TOP], 1u);
            const unsigned tg = og / nx;
            if (og + 1u == (tg + 1u) * nx) xb_add(&bar[XB_TOPGEN], 1u);
            else XB_SPIN(xb_ld(&bar[XB_TOPGEN]) == tg, bar);
            __builtin_amdgcn_fence(__ATOMIC_ACQUIRE, "agent");
            xb_add(&bar[XB_XGEN(b.x)], 1u);
            asm volatile("s_waitcnt vmcnt(0)" ::: "memory");
        } else {
            XB_SPIN(xb_ld(&bar[XB_XGEN(b.x)]) == gen, bar);
            __builtin_amdgcn_fence(__ATOMIC_ACQUIRE, "agent");
            asm volatile("s_waitcnt vmcnt(0)" ::: "memory");
        }
    }
    __syncthreads();
}

struct Args {
    const float* xp; const float* xs; const float* ln_in_g; const float* ln_in_b; const float* w_in; const float* lb_logits; const float* hg_norm_g; const float* attn_sink;
    const float* w_a; const float* w_b; const float* w_out; const float* ln1_g; const float* ln1_b; const float* w_ffn_in; const float* w_ffn_out; const float* ln2_g; const float* ln2_b;
    float* out; unsigned char* ws; int ph_lo, ph_hi;
};

__device__ __forceinline__ float wave_sum(float v) {
#pragma unroll
    for (int o = 1; o < 64; o <<= 1) v += __shfl_xor(v, o);
    return v;
}

__device__ __forceinline__ void row_norm(const float* st, int row, float& A, float& B) {
    const int2 si = *(const int2*)(st + 2 * (size_t)row); float2 s; s.x = (float)si.x * STAT_S1; s.y = (float)si.y * STAT_S2;
    const float mean = s.x * (1.0f / DM); const float var = fmaxf(s.y * (1.0f / DM) - mean * mean, 0.f);
    const float rstd = 1.0f / sqrtf(var + LN_EPS); A = rstd; B = -mean * rstd;
}

template <int MAPKIND>
__device__ __forceinline__ int colmap(int n) {
    if (MAPKIND == 1) { if (n >= 6656) { const int t = (n - 6656) >> 8, i = (n - 6656) & 255; return (i < 128) ? (6656 + 128 * t + i) : (8704 + 128 * t + (i - 128)); }
        if (n >= 5120 && n < 6400) { const int hb = n & ~127, p = n & 127, j8 = p >> 3, e = p & 7; return hb + ((e < 4) ? (4 * j8 + e) : (64 + 4 * j8 + (e - 4))); } return n; }
    if (MAPKIND == 2) { const int t = n >> 8, i = n & 255; return (i < 128) ? (128 * t + i) : (DFF + 128 * t + (i - 128)); }
    return n;
}
template <int MAPKIND, bool FOLD>
__device__ __forceinline__ void transpose_item(const float* W, int K, int N, bf16* WT, int ldk, const float* gain, const float* bias, float* c1, float* c2, LAS float* scr, int item, int lane) {
    const int nblk = N / 32, kb = item / nblk, nb = item % nblk, k0 = 64 * kb, n0 = 32 * nb;
    const int ncol = colmap<MAPKIND>(n0 + (lane & 31));
    float s1 = 0.f, s2 = 0.f;
#pragma unroll 8
    for (int i = 0; i < 32; ++i) { const int kk = 2 * i + (lane >> 5); float w = W[(size_t)(k0 + kk) * N + ncol];
        if (FOLD) { const float gk = gain[k0 + kk], bk = bias[k0 + kk]; s2 += bk * w; w *= gk; s1 += __uint_as_float(f2bf(w) << 16); }
        scr[kk * 33 + (lane & 31)] = w; }
    if (FOLD) { s1 += __shfl_xor(s1, 32); s2 += __shfl_xor(s2, 32); if (lane < 32) { atomicAdd(c1 + n0 + lane, qfix<19>(s1)); atomicAdd(c2 + n0 + lane, qfix<21>(s2)); } }
    asm volatile("s_waitcnt lgkmcnt(0)" ::: "memory");
    const int c = lane & 7;
#pragma unroll
    for (int j = 0; j < 4; ++j) { const int n = (lane >> 3) + 8 * j; const LAS float* s = scr + (8 * c) * 33 + n;
        u32x4 o; o.x = pk2(s[0 * 33], s[1 * 33]); o.y = pk2(s[2 * 33], s[3 * 33]); o.z = pk2(s[4 * 33], s[5 * 33]); o.w = pk2(s[6 * 33], s[7 * 33]);
        *(u32x4*)(WT + (size_t)(n0 + n) * ldk + k0 + 8 * c) = o; }
    asm volatile("s_waitcnt lgkmcnt(0)" ::: "memory");
}

__device__ __forceinline__ void convert_layer(const Args& a, int l, LAS unsigned char* lds, int gw, int ngw, int wave, int lane) {
    LAS float* scr = (LAS float*)(lds + wave * 16384);
    unsigned char* wsw = a.ws + WS_W;
    float* cv = (float*)(a.ws + WS_CVEC + (size_t)l * CVEC_LAYER);
    const float* g_in = l == 0 ? a.ln_in_g : a.ln2_g + (size_t)(l - 1) * DM;
    const float* b_in = l == 0 ? a.ln_in_b : a.ln2_b + (size_t)(l - 1) * DM;
    constexpr int I_IN = (DM / 64) * (NPROJ / 32), I_A = (HW / 64) * (DM / 32), I_OUT = (DM / 64) * (DM / 32), I_FIN = (DM / 64) * (NFFN / 32), I_FOUT = (DFF / 64) * (DM / 32);
    constexpr int NITEMS = I_IN + 2 * I_A + I_OUT + I_FIN + I_FOUT;
    for (int it = gw; it < NITEMS; it += ngw) {
        int r = it;
        if (r < I_IN) { transpose_item<1, true>(a.w_in + (size_t)l * DM * NPROJ, DM, NPROJ, (bf16*)(wsw + W_IN), DM, g_in, b_in, cv, cv + NPROJ, scr, r, lane); continue; } r -= I_IN;
        if (r < I_FIN) { transpose_item<2, true>(a.w_ffn_in + (size_t)l * DM * NFFN, DM, NFFN, (bf16*)(wsw + W_FIN), DM, a.ln1_g + (size_t)l * DM, a.ln1_b + (size_t)l * DM, cv + 2 * NPROJ, cv + 2 * NPROJ + NFFN, scr, r, lane); continue; } r -= I_FIN;
        if (r < I_FOUT) { transpose_item<0, false>(a.w_ffn_out + (size_t)l * DFF * DM, DFF, DM, (bf16*)(wsw + W_FOUT), DFF, nullptr, nullptr, nullptr, nullptr, scr, r, lane); continue; } r -= I_FOUT;
        if (r < I_OUT) { transpose_item<0, false>(a.w_out + (size_t)l * DM * DM, DM, DM, (bf16*)(wsw + W_OUT), DM, nullptr, nullptr, nullptr, nullptr, scr, r, lane); continue; } r -= I_OUT;
        if (r < I_A) { transpose_item<0, false>(a.w_a + (size_t)l * HW * DM, HW, DM, (bf16*)(wsw + W_A), DM, nullptr, nullptr, nullptr, nullptr, scr, r, lane); continue; } r -= I_A;
        transpose_item<0, false>(a.w_b + (size_t)l * HW * DM, HW, DM, (bf16*)(wsw + W_A) + HW, DM, nullptr, nullptr, nullptr, nullptr, scr, r, lane);
    }
}

__device__ __forceinline__ const float* xrow_ptr(const Args& a, int m) { return m < NSEQ_P * SEQ_P ? a.xp + (size_t)m * DM : a.xs + (size_t)(m - NSEQ_P * SEQ_P) * DM; }

__device__ __forceinline__ void prologue(const Args& a, int gw, int ngw, int lane) {
    { float* lb = (float*)(a.ws + WS_LB);
      for (int c = gw * 64 + lane; c < 2048; c += ngw * 64) {
          float v[DEPTH], mx = -1e30f, s = 0.f;
#pragma unroll
          for (int l = 0; l < DEPTH; ++l) { v[l] = a.lb_logits[l * 2048 + c]; mx = fmaxf(mx, v[l]); }
#pragma unroll
          for (int l = 0; l < DEPTH; ++l) { v[l] = expf(v[l] - mx); s += v[l]; }
          float cum = 0.f;
#pragma unroll
          for (int l = 0; l < DEPTH; ++l) { const float p = v[l] / s; cum += p; lb[l * 2048 + c] = cum - v[0] / s; }
      } }
    { float* ct = (float*)(a.ws + WS_COS); float* st = (float*)(a.ws + WS_SIN);
      for (int i = gw * 64 + lane; i < SEQ_S * 64; i += ngw * 64) { const int pos = i >> 6, j = i & 63;
          const double inv = pow(10000.0, -(double)(2 * j) / 128.0); const double ang = (double)pos * inv; ct[i] = (float)cos(ang); st[i] = (float)sin(ang); } }
    { float* st0 = (float*)(a.ws + WS_STATS); bf16* ybf = (bf16*)(a.ws + WS_YBF);
      for (int m = gw; m < MTOK; m += ngw) {
          const f32x4* xr = (const f32x4*)xrow_ptr(a, m) + lane; float s = 0.f, s2 = 0.f;
          unsigned long long* o8 = (unsigned long long*)(ybf + (size_t)m * DM) + lane;
#pragma unroll
          for (int j = 0; j < 8; ++j) { const f32x4 v = xr[64 * j]; s += (v.x + v.y) + (v.z + v.w); s2 += (v.x * v.x + v.y * v.y) + (v.z * v.z + v.w * v.w);
              o8[64 * j] = (unsigned long long)pk2(v.x, v.y) | ((unsigned long long)pk2(v.z, v.w) << 32); }
          s = wave_sum(s); s2 = wave_sum(s2);
          if (lane == 0) { ((int*)st0)[2 * (size_t)m] = (int)rintf(s * STAT_Q1); ((int*)st0)[2 * (size_t)m + 1] = (int)rintf(s2 * STAT_Q2); }
      } }
}

typedef pg8::f32x4 (&AccRef)[2][2][4][2];
template <class T> __device__ __forceinline__ T ldg(const void* base, unsigned off) { return *(const GAS T*)((const GAS char*)base + off); }
template <class T> __device__ __forceinline__ void stg(void* base, unsigned off, T v) { *(GAS T*)((GAS char*)base + off) = v; }
__device__ __forceinline__ void row_norm_o(const float* st, unsigned off8, float& A, float& B) {
    const i32x2 si = ldg<i32x2>(st, off8); f32x2 s; s.x = (float)si.x * STAT_S1; s.y = (float)si.y * STAT_S2;
    const float mean = s.x * (1.0f / DM); const float var = fmaxf(s.y * (1.0f / DM) - mean * mean, 0.f);
    const float rstd = 1.0f / sqrtf(var + LN_EPS); A = rstd; B = -mean * rstd;
}

__device__ __forceinline__ void load_row_norms(const float* st, int row0, float (&A)[8], float (&B)[8]) {
    i32x2 sv[8];
#pragma unroll
    for (int i = 0; i < 8; ++i) sv[i] = ldg<i32x2>(st, (unsigned)((row0 + (i >> 2) * 128 + (i & 3) * 16) * 8));
#pragma unroll
    for (int i = 0; i < 8; ++i) { const float mean = (float)sv[i].x * (STAT_S1 / DM); const float var = fmaxf((float)sv[i].y * (STAT_S2 / DM) - mean * mean, 0.f);
        const float rstd = 1.0f / sqrtf(var + LN_EPS); A[i] = rstd; B[i] = -mean * rstd; }
}

__device__ __forceinline__ void lds_row_norms(const LAS unsigned char* sm, int rl0, float (&A)[8], float (&B)[8]) {
    i32x2 sv[8];
#pragma unroll
    for (int i = 0; i < 8; ++i) sv[i] = *(const LAS i32x2*)(sm + (rl0 + (i >> 2) * 128 + (i & 3) * 16) * 8);
#pragma unroll
    for (int i = 0; i < 8; ++i) { const float mean = (float)sv[i].x * (STAT_S1 / DM); const float var = fmaxf((float)sv[i].y * (STAT_S2 / DM) - mean * mean, 0.f);
        const float rstd = 1.0f / sqrtf(var + LN_EPS); A[i] = rstd; B[i] = -mean * rstd; }
}
__device__ __forceinline__ void prefetch_stats(const float* stats, int pm, LAS unsigned char* sm, int wid, int lane) {
    if (wid == 0) { pg8::dma16(stats, (unsigned)(pm * 2048 + lane * 16), sm); pg8::dma16(stats, (unsigned)(pm * 2048 + 1024 + lane * 16), sm + 1024); } }

struct EpiProj {
    static constexpr bool PERM = true, HAS_MID = false, F16 = false;
    unsigned char* ws; const float* stats; const float* c1; const float* c2; const float* lb;
    __device__ __forceinline__ void prefetch(LAS unsigned char* sm, const pg8::Unit& u, int wid, int lane) const {
        prefetch_stats(stats, u.pm, sm, wid, lane);
        if (wid == 1) { pg8::dma16(c1, (unsigned)(u.pn * 1024 + lane * 16), sm + 2048); pg8::dma16(c2, (unsigned)(u.pn * 1024 + lane * 16), sm + 3072); }
        if (wid == 2 && u.pn >= 4 && u.pn < 12) pg8::dma16(lb, (unsigned)((u.pn - 4) * 1024 + lane * 16), sm + 4096);
    }
    __device__ __forceinline__ void operator()(AccRef acc, const pg8::Unit& u, int wr, int wc, int fr, int fq, const LAS unsigned char* sm) const {
        const int pn = u.pn, row0 = u.pm * 256 + wr * 64 + fr, cl = wc * 32 + 8 * fq, colg = pn * 256 + cl;
        int type, ldc, dcol; size_t dbase;
        if (pn < 4)       { type = 0; dbase = P_HQ;  ldc = HW;  dcol = pn * 256; }
        else if (pn < 8)  { type = 1; dbase = P_GF;  ldc = HW;  dcol = (pn - 4) * 256; }
        else if (pn < 12) { type = 1; dbase = P_GB;  ldc = HW;  dcol = (pn - 8) * 256; }
        else if (pn < 16) { type = 2; dbase = P_HI;  ldc = HW;  dcol = (pn - 12) * 256; }
        else if (pn < 20) { type = 0; dbase = P_HG;  ldc = HW;  dcol = (pn - 16) * 256; }
        else if (pn < 24) { type = 3; dbase = P_AQ;  ldc = HW;  dcol = (pn - 20) * 256; }
        else if (pn < 25) { type = 4; dbase = P_AK;  ldc = KVW; dcol = 0; }
        else if (pn < 26) { type = 2; dbase = P_AV;  ldc = KVW; dcol = 0; }
        else              { type = 5; dbase = P_GA;  ldc = DM;  dcol = (pn - 26) * 128; }
        unsigned char* dst = ws + dbase;
        const unsigned doff0 = (unsigned)((row0 * ldc + dcol + cl) * 2), dstep = (unsigned)(16 * ldc * 2);
        const int pos0 = (u.pm < 128 ? ((u.pm & 7) * 256) : ((u.pm - 128) * 256)) + wr * 64 + fr;
        const unsigned roff0 = (unsigned)(pos0 * 256 + (16 * wc + 4 * fq) * 4);
        const float* cost = (const float*)(ws + WS_COS); const float* sint = (const float*)(ws + WS_SIN);
        float A[8], B[8]; lds_row_norms(sm, wr * 64 + fr, A, B);
        if (type == 5) {
            unsigned char* dstb = ws + P_GBB;
            pg8::f32x4 c1v[2][2], c2v[2][2];
#pragma unroll
            for (int bj = 0; bj < 2; ++bj)
#pragma unroll
                for (int n = 0; n < 2; ++n) { c1v[bj][n] = *(const LAS pg8::f32x4*)(sm + 2048 + (cl + bj * 128 + 4 * n) * 4); c2v[bj][n] = *(const LAS pg8::f32x4*)(sm + 3072 + (cl + bj * 128 + 4 * n) * 4) * (-LOG2E); }
            asm volatile("" ::: "memory");
#pragma unroll
            for (int ai = 0; ai < 2; ++ai)
#pragma unroll
                for (int m = 0; m < 4; ++m) {
                    const float Ar = -LOG2E * A[ai * 4 + m], Br = -LOG2E * B[ai * 4 + m];
                    float rt[8], gb[8];
#pragma unroll
                    for (int n = 0; n < 2; ++n)
#pragma unroll
                        for (int j = 0; j < 4; ++j) {
                            const float xa = __builtin_fmaf(acc[ai][0][m][n][j], Ar, __builtin_fmaf(c1v[0][n][j], Br, c2v[0][n][j])), xb = __builtin_fmaf(acc[ai][1][m][n][j], Ar, __builtin_fmaf(c1v[1][n][j], Br, c2v[1][n][j]));
                            const float ea = 1.0f + fexp2(fminf(xa, 80.f)), eb = 1.0f + fexp2(fminf(xb, 80.f)); gb[4 * n + j] = frcp(eb); rt[4 * n + j] = eb * frcp(ea); }
                    u32x4 wr_, wg_; wr_.x = pk2(rt[0], rt[1]); wr_.y = pk2(rt[2], rt[3]); wr_.z = pk2(rt[4], rt[5]); wr_.w = pk2(rt[6], rt[7]);
                    wg_.x = pk2(gb[0], gb[1]); wg_.y = pk2(gb[2], gb[3]); wg_.z = pk2(gb[4], gb[5]); wg_.w = pk2(gb[6], gb[7]);
                    const unsigned o = doff0 + (unsigned)(ai * 8 + m) * dstep;
                    stg<u32x4>(dst, o, wr_); stg<u32x4>(dstb, o, wg_);
                }
            return;
        }
#pragma unroll
        for (int bj = 0; bj < 2; ++bj) {
            pg8::f32x4 c1v[2], c2v[2], lbv[2];
#pragma unroll
            for (int n = 0; n < 2; ++n) { c1v[n] = *(const LAS pg8::f32x4*)(sm + 2048 + (cl + bj * 128 + 4 * n) * 4); c2v[n] = *(const LAS pg8::f32x4*)(sm + 3072 + (cl + bj * 128 + 4 * n) * 4);
                lbv[n] = (type == 1) ? *(const LAS pg8::f32x4*)(sm + 4096 + (cl + bj * 128 + 4 * n) * 4) : (pg8::f32x4){0.f, 0.f, 0.f, 0.f}; }
            asm volatile("" ::: "memory");
#pragma unroll
            for (int ai = 0; ai < 2; ++ai) {
                pg8::f32x4 cs[4], sn[4];
                if (type == 3 || type == 4) {
#pragma unroll
                    for (int m = 0; m < 4; ++m) { cs[m] = ldg<pg8::f32x4>(cost, roff0 + (unsigned)((ai * 128 + m * 16) * 256)); sn[m] = ldg<pg8::f32x4>(sint, roff0 + (unsigned)((ai * 128 + m * 16) * 256)); }
                    asm volatile("" ::: "memory");
                }
#pragma unroll
                for (int m = 0; m < 4; ++m) {
                    const float Ar = A[ai * 4 + m], Br = B[ai * 4 + m];
                    pg8::f32x4 v[2];
#pragma unroll
                    for (int n = 0; n < 2; ++n)
#pragma unroll
                        for (int j = 0; j < 4; ++j) v[n][j] = __builtin_fmaf(acc[ai][bj][m][n][j], Ar, __builtin_fmaf(c1v[n][j], Br, c2v[n][j]));
                    if (type == 0) {
#pragma unroll
                        for (int n = 0; n < 2; ++n)
#pragma unroll
                            for (int j = 0; j < 4; ++j) v[n][j] = v[n][j] * frcp(1.0f + fexp2(v[n][j] * -LOG2E));
                    } else if (type == 1) {
#pragma unroll
                        for (int n = 0; n < 2; ++n)
#pragma unroll
                            for (int j = 0; j < 4; ++j) { const float lbx = lbv[n][j]; const float f = __builtin_fmaf(1.0f - lbx, frcp(1.0f + fexp2(v[n][j] * -LOG2E)), lbx); v[n][j] = __builtin_amdgcn_logf(fmaxf(f, 1e-30f)); }
                    } else if (type == 3 || type == 4) {
                        const float sc = type == 3 ? QSCALE : 1.0f;
                        const pg8::f32x4 x1 = v[0], x2 = v[1]; v[0] = (x1 * cs[m] - x2 * sn[m]) * sc; v[1] = (x2 * cs[m] + x1 * sn[m]) * sc;
                    }
                    u32x4 w; w.x = pk2(v[0][0], v[0][1]); w.y = pk2(v[0][2], v[0][3]); w.z = pk2(v[1][0], v[1][1]); w.w = pk2(v[1][2], v[1][3]);
                    stg<u32x4>(dst, doff0 + (unsigned)(ai * 8 + m) * dstep + bj * 256, w);
                }
            }
        }
    }
};

struct EpiMergeF {
    static constexpr bool PERM = true, HAS_MID = true, F16 = false;
    const bf16* ratio; const bf16* gateb; bf16* merged;
    __device__ __forceinline__ void mid(AccRef acc, const pg8::Unit& u, int wr, int wc, int fr, int fq) const {
        const int row0 = u.pm * 256 + wr * 64 + fr, col0 = u.pn * 256 + wc * 32 + 8 * fq;
        const unsigned off0 = (unsigned)((row0 * DM + col0) * 2);
        u32x4 gv[2][4][2];
#pragma unroll
        for (int ai = 0; ai < 2; ++ai)
#pragma unroll
            for (int m = 0; m < 4; ++m)
#pragma unroll
                for (int bj = 0; bj < 2; ++bj) gv[ai][m][bj] = ldg<u32x4>(ratio, off0 + (unsigned)((ai * 128 + m * 16) * DM * 2) + bj * 256);
        asm volatile("" ::: "memory");
#pragma unroll
        for (int ai = 0; ai < 2; ++ai)
#pragma unroll
            for (int m = 0; m < 4; ++m)
#pragma unroll
                for (int bj = 0; bj < 2; ++bj)
#pragma unroll
                    for (int j = 0; j < 8; ++j) { const unsigned gw_ = gv[ai][m][bj][j >> 1]; const float gg = (j & 1) ? __uint_as_float(gw_ & 0xffff0000u) : __uint_as_float(gw_ << 16); acc[ai][bj][m][j >> 2][j & 3] *= gg; }
    }
    __device__ __forceinline__ void prefetch(LAS unsigned char*, const pg8::Unit&, int, int) const {}
    __device__ __forceinline__ void operator()(AccRef acc, const pg8::Unit& u, int wr, int wc, int fr, int fq, const LAS unsigned char*) const {
        const int row0 = u.pm * 256 + wr * 64 + fr, col0 = u.pn * 256 + wc * 32 + 8 * fq;
        const unsigned off0 = (unsigned)((row0 * DM + col0) * 2);
        u32x4 gva[2][4][2];
#pragma unroll
        for (int ai = 0; ai < 2; ++ai)
#pragma unroll
            for (int m = 0; m < 4; ++m)
#pragma unroll
                for (int bj = 0; bj < 2; ++bj) gva[ai][m][bj] = ldg<u32x4>(gateb, off0 + (unsigned)((ai * 128 + m * 16) * DM * 2) + bj * 256);
        asm volatile("" ::: "memory");
#pragma unroll
        for (int ai = 0; ai < 2; ++ai) {
#pragma unroll
            for (int m = 0; m < 4; ++m)
#pragma unroll
                for (int bj = 0; bj < 2; ++bj) { float r[8];
#pragma unroll
                    for (int j = 0; j < 8; ++j) { const unsigned gw_ = gva[ai][m][bj][j >> 1]; const float gg = (j & 1) ? __uint_as_float(gw_ & 0xffff0000u) : __uint_as_float(gw_ << 16); r[j] = gg * acc[ai][bj][m][j >> 2][j & 3]; }
                    u32x4 w; w.x = pk2(r[0], r[1]); w.y = pk2(r[2], r[3]); w.z = pk2(r[4], r[5]); w.w = pk2(r[6], r[7]);
                    stg<u32x4>(merged, off0 + (unsigned)((ai * 128 + m * 16) * DM * 2) + bj * 256, w); }
        }
    }
};

template <int SRC> struct EpiResid {
    static constexpr bool PERM = true, HAS_MID = false, F16 = false;
    const float* srcp; const float* srcs; const unsigned short* y16src;
    const float* stats_in; const float* g; const float* b; unsigned short* y16dst; bf16* ybfdst; float* y32dst; float* stats_out;
    __device__ __forceinline__ void prefetch(LAS unsigned char* sm, const pg8::Unit& u, int wid, int lane) const {
        prefetch_stats(stats_in, u.pm, sm, wid, lane);
        if (wid == 1) { pg8::dma16(g, (unsigned)(u.pn * 1024 + lane * 16), sm + 2048); pg8::dma16(b, (unsigned)(u.pn * 1024 + lane * 16), sm + 3072); }
    }
    __device__ __forceinline__ void operator()(AccRef acc, const pg8::Unit& u, int wr, int wc, int fr, int fq, const LAS unsigned char* sm) const {
        const int row0 = u.pm * 256 + wr * 64 + fr, col0 = u.pn * 256 + wc * 32 + 8 * fq;
        const bool samp = u.pm >= 128;
        const float* src = samp ? srcs : srcp;
        const unsigned yoff0 = (unsigned)((row0 * DM + col0) * 2);
        const unsigned xoff0 = samp ? 2 * yoff0 - (unsigned)(NSEQ_P * SEQ_P) * DM * 4u : 2 * yoff0;
        float A[8], B[8]; lds_row_norms(sm, wr * 64 + fr, A, B);
        float ssum[8], ssq[8];
#pragma unroll
        for (int i = 0; i < 8; ++i) { ssum[i] = 0.f; ssq[i] = 0.f; }
        u32x4 raw[4], nraw[4];
        if (SRC != 0) {
#pragma unroll
            for (int m = 0; m < 4; ++m) raw[m] = ldg<u32x4>(y16src, yoff0 + (unsigned)((m * 16) * DM * 2));
        }
#pragma unroll
        for (int bj = 0; bj < 2; ++bj) {
            pg8::f32x4 gv[2], bv[2];
#pragma unroll
            for (int n = 0; n < 2; ++n) { gv[n] = *(const LAS pg8::f32x4*)(sm + 2048 + (wc * 32 + 8 * fq + bj * 128 + 4 * n) * 4) * ALPHA; bv[n] = *(const LAS pg8::f32x4*)(sm + 3072 + (wc * 32 + 8 * fq + bj * 128 + 4 * n) * 4) * ALPHA; }
#pragma unroll
            for (int ai = 0; ai < 2; ++ai) {
                pg8::f32x4 yv[4][2];
                if (SRC == 0) {
#pragma unroll
                    for (int m = 0; m < 4; ++m)
#pragma unroll
                        for (int n = 0; n < 2; ++n) yv[m][n] = ldg<pg8::f32x4>(src, xoff0 + (unsigned)((ai * 128 + m * 16) * DM * 4) + bj * 512 + 16 * n);
                } else {
                    if (bj * 2 + ai < 3) { const int nb_ = (bj * 2 + ai + 1) >> 1, na_ = (bj * 2 + ai + 1) & 1;
#pragma unroll
                        for (int m = 0; m < 4; ++m) nraw[m] = ldg<u32x4>(y16src, yoff0 + (unsigned)((na_ * 128 + m * 16) * DM * 2) + nb_ * 256); }
                }
                asm volatile("" ::: "memory");
#pragma unroll
                for (int m = 0; m < 4; ++m) {
                    const float Ar = A[ai * 4 + m], Br = B[ai * 4 + m]; const unsigned yoff = yoff0 + (unsigned)((ai * 128 + m * 16) * DM * 2) + bj * 256;
                    pg8::f32x4 o[2];
#pragma unroll
                    for (int n = 0; n < 2; ++n) {
                        const pg8::f32x4 yy = SRC == 0 ? yv[m][n] : (pg8::f32x4){h2f_lo(raw[m][2 * n]), h2f_hi(raw[m][2 * n]), h2f_lo(raw[m][2 * n + 1]), h2f_hi(raw[m][2 * n + 1])};
                        o[n] = ((yy * Ar + Br) * gv[n] + bv[n]) + acc[ai][bj][m][n];
                        ssum[ai * 4 + m] += (o[n][0] + o[n][1]) + (o[n][2] + o[n][3]); ssq[ai * 4 + m] += (o[n][0] * o[n][0] + o[n][1] * o[n][1]) + (o[n][2] * o[n][2] + o[n][3] * o[n][3]); }
                    if (y32dst) { stg<pg8::f32x4>(y32dst, 2 * yoff, o[0]); stg<pg8::f32x4>(y32dst, 2 * yoff + 16, o[1]); }
                    if (y16dst) { u32x4 w; w.x = pk2h(o[0][0], o[0][1]); w.y = pk2h(o[0][2], o[0][3]); w.z = pk2h(o[1][0], o[1][1]); w.w = pk2h(o[1][2], o[1][3]); stg<u32x4>(y16dst, yoff, w); }
                    if (ybfdst) { u32x4 w; w.x = pk2(o[0][0], o[0][1]); w.y = pk2(o[0][2], o[0][3]); w.z = pk2(o[1][0], o[1][1]); w.w = pk2(o[1][2], o[1][3]); stg<u32x4>(ybfdst, yoff, w); }
                }
                asm volatile("" ::: "memory");
                if (SRC != 0) {
#pragma unroll
                    for (int m = 0; m < 4; ++m) raw[m] = nraw[m]; }
            }
        }
        int fr2 = fr, fq2 = fq; asm volatile("" : "+v"(fr2), "+v"(fq2));
        const unsigned soff0 = (unsigned)((u.pm * 256 + wr * 64 + fr2) * 8 + 4 * fq2);
#pragma unroll
        for (int i = 0; i < 8; ++i) { float s = ssum[i], s2 = ssq[i];
            s += __shfl_xor(s, 16); s += __shfl_xor(s, 32); s2 += __shfl_xor(s2, 16); s2 += __shfl_xor(s2, 32);
            const int iv = (fq2 == 0) ? (int)rintf(s * STAT_Q1) : (int)rintf(s2 * STAT_Q2);
            if (fq2 < 2) __hip_atomic_fetch_add((GAS int*)((GAS char*)stats_out + soff0 + (unsigned)(((i >> 2) * 128 + (i & 3) * 16) * 8)), iv, __ATOMIC_RELAXED, __HIP_MEMORY_SCOPE_AGENT); }
    }
};

struct EpiSwiglu {
    static constexpr bool PERM = true, HAS_MID = false, F16 = false;
    const float* stats; const float* c1; const float* c2; bf16* hid;
    __device__ __forceinline__ void prefetch(LAS unsigned char* sm, const pg8::Unit& u, int wid, int lane) const {
        prefetch_stats(stats, u.pm, sm, wid, lane);
        if (wid == 1) { pg8::dma16(c1, (unsigned)(u.pn * 1024 + lane * 16), sm + 2048); pg8::dma16(c2, (unsigned)(u.pn * 1024 + lane * 16), sm + 3072); }
    }
    __device__ __forceinline__ void operator()(AccRef acc, const pg8::Unit& u, int wr, int wc, int fr, int fq, const LAS unsigned char* sm) const {
        const int row0 = u.pm * 256 + wr * 64 + fr, cl = wc * 32 + 8 * fq;
        float A[8], B[8]; lds_row_norms(sm, wr * 64 + fr, A, B);
        pg8::f32x4 c1v[2][2], c2v[2][2];
#pragma unroll
        for (int bj = 0; bj < 2; ++bj)
#pragma unroll
            for (int n = 0; n < 2; ++n) { c1v[bj][n] = *(const LAS pg8::f32x4*)(sm + 2048 + (cl + bj * 128 + 4 * n) * 4); c2v[bj][n] = *(const LAS pg8::f32x4*)(sm + 3072 + (cl + bj * 128 + 4 * n) * 4); }
        asm volatile("" ::: "memory");
        const unsigned hoff0 = (unsigned)((row0 * DFF + u.pn * 128 + cl) * 2);
#pragma unroll
        for (int ai = 0; ai < 2; ++ai)
#pragma unroll
            for (int m = 0; m < 4; ++m) {
                const float Ar = A[ai * 4 + m], Br = B[ai * 4 + m];
                float r[8];
#pragma unroll
                for (int n = 0; n < 2; ++n)
#pragma unroll
                    for (int j = 0; j < 4; ++j) { const float gt = __builtin_fmaf(acc[ai][0][m][n][j], Ar, __builtin_fmaf(c1v[0][n][j], Br, c2v[0][n][j])), up = __builtin_fmaf(acc[ai][1][m][n][j], Ar, __builtin_fmaf(c1v[1][n][j], Br, c2v[1][n][j]));
                        r[4 * n + j] = gt * up * frcp(1.0f + fexp2(gt * -LOG2E)); }
                u32x4 w; w.x = pk2(r[0], r[1]); w.y = pk2(r[2], r[3]); w.z = pk2(r[4], r[5]); w.w = pk2(r[6], r[7]);
                stg<u32x4>(hid, hoff0 + (unsigned)((ai * 128 + m * 16) * DFF * 2), w);
            }
    }
};

__device__ __forceinline__ unsigned off_b(unsigned row, unsigned ch) { return 256u * row + 16u * (ch ^ (((row & 3) << 2) | ((row >> 2) & 3))); }
__device__ __forceinline__ bf16x8 frag_row(const LAS unsigned char* img, int r0, int ks, int lane) { return *(const LAS bf16x8*)(img + off_b(r0 + (lane & 31), 2 * ks + (lane >> 5))); }
__device__ __forceinline__ bf16x8 frag_tr(const LAS unsigned char* img, int k0, int c0, int lane) {
    const unsigned h = lane >> 5, blk = (lane >> 4) & 1, q = (lane & 15) >> 2, p = lane & 3;
    const unsigned ch = (unsigned)(c0 >> 3) + 2 * blk + (p >> 1);
    const s16x4 lo = __builtin_amdgcn_ds_read_tr16_b64_v4i16((LAS s16x4*)(img + off_b(k0 + 8 * h + q, ch) + 8 * (p & 1)));
    const s16x4 hi = __builtin_amdgcn_ds_read_tr16_b64_v4i16((LAS s16x4*)(img + off_b(k0 + 8 * h + 4 + q, ch) + 8 * (p & 1)));
    return (bf16x8){lo[0], lo[1], lo[2], lo[3], hi[0], hi[1], hi[2], hi[3]};
}
__device__ __forceinline__ bf16x8 frag_tr_acc(const LAS unsigned char* img, int k0, int c0, int lane) {
    const unsigned h = lane >> 5, blk = (lane >> 4) & 1, q = (lane & 15) >> 2, p = lane & 3;
    const unsigned ch = (unsigned)(c0 >> 3) + 2 * blk + (p >> 1);
    const s16x4 lo = __builtin_amdgcn_ds_read_tr16_b64_v4i16((LAS s16x4*)(img + off_b(k0 + 4 * h + q, ch) + 8 * (p & 1)));
    const s16x4 hi = __builtin_amdgcn_ds_read_tr16_b64_v4i16((LAS s16x4*)(img + off_b(k0 + 8 + 4 * h + q, ch) + 8 * (p & 1)));
    return (bf16x8){lo[0], lo[1], lo[2], lo[3], hi[0], hi[1], hi[2], hi[3]};
}
__device__ __forceinline__ int crow(int r, int h) { return (r & 3) + 8 * (r >> 2) + 4 * h; }
#define MFMA32(A, B, C) __builtin_amdgcn_mfma_f32_32x32x16_bf16((A), (B), (C), 0, 0, 0)

constexpr int SC_RQ = 0, SC_RG = 16384, SC_VI = 32768, SC_SI = 49152, SC_QT = 81920, SC_KT = 100352, SC_AI = 118784, SC_EM = 128000, SC_EE = 128512, SC_EME = 129024, SC_END = 129536;
constexpr int T_STR = 144, AI_STR = 144;
static_assert(SC_END <= RING_BYTES, "scan LDS");
__device__ __forceinline__ bf16x8 frag_tr144(const LAS unsigned char* img, int k0, int c0, int lane) {
    const unsigned h = lane >> 5, blk = (lane >> 4) & 1, q = (lane & 15) >> 2, p = lane & 3;
    const LAS unsigned char* ad = img + (k0 + 8 * h + q) * T_STR + (c0 + 16 * blk + 4 * p) * 2;
    const s16x4 lo = __builtin_amdgcn_ds_read_tr16_b64_v4i16((LAS s16x4*)ad);
    const s16x4 hi = __builtin_amdgcn_ds_read_tr16_b64_v4i16((LAS s16x4*)(ad + 4 * T_STR));
    return (bf16x8){lo[0], lo[1], lo[2], lo[3], hi[0], hi[1], hi[2], hi[3]};
}
constexpr int SC_BEL = 129536;
static_assert(SC_BEL + 512 <= RING_BYTES, "scan LDS");
template <int MODE>
__device__ __forceinline__ void scan_unit(const Args& a, LAS unsigned char* lds, int rowbase, int head, int dir, int seg, int tid, int wave, int lane) {
    constexpr int L = SEQ_P; constexpr int mode = MODE;
    const unsigned char* hq = a.ws + P_HQ; const unsigned char* gg = a.ws + (dir ? P_GB : P_GF); const unsigned char* hv = a.ws + P_HI;
    unsigned char* oraw = a.ws + (dir ? WS_OBWD : WS_AOUT);
    LAS unsigned char* RQ = lds + SC_RQ; LAS unsigned char* RG = lds + SC_RG; LAS unsigned char* VI = lds + SC_VI; LAS unsigned char* SI = lds + SC_SI;
    LAS unsigned char* QT = lds + SC_QT; LAS unsigned char* KT = lds + SC_KT; LAS unsigned char* AI = lds + SC_AI;
    LAS float* em = (LAS float*)(lds + SC_EM); LAS float* ee = (LAS float*)(lds + SC_EE); LAS float* eme = (LAS float*)(lds + SC_EME); LAS float* bel = (LAS float*)(lds + SC_BEL);
    const int h = lane >> 5, l31 = lane & 31, blk = (lane >> 4) & 1, q4 = (lane & 15) >> 2, p = lane & 3;
    const int tb = wave >> 2, kb = wave & 3;
    constexpr bool passA = MODE == 1;
    bf16x8 Ld[2], Lone;
#pragma unroll
    for (int ksl = 0; ksl < 2; ++ksl)
#pragma unroll
        for (int j = 0; j < 8; ++j) Ld[ksl][j] = (16 * ksl + 8 * h + j <= l31) ? (short)0x3F80 : (short)0;
#pragma unroll
    for (int j = 0; j < 8; ++j) Lone[j] = (short)0x3F80;
    const int kk0 = 32 * ((2 * wave) & 3) + l31, kk1 = 32 * ((2 * wave + 1) & 3) + l31;
    f32x16 S0, S1;
#pragma unroll
    for (int r = 0; r < 16; ++r) { S0[r] = 0.f; S1[r] = 0.f; }
    float dlog0 = 0.f, dlog1 = 0.f;
    if (mode == 2) {
        const int nprev = dir ? (3 - seg) : seg;
        for (int i = 0; i < nprev; ++i) { const int sg = dir ? (3 - i) : i; const int slot = (sg * 8 + head) * 2 + dir;
            const float* E = (const float*)(a.ws + WS_SEGE) + ((size_t)slot * 512 + tid) * 32; const float* D = (const float*)(a.ws + WS_SEGD) + slot * 128;
            const float d0 = fexp2(D[kk0]), d1 = fexp2(D[kk1]);
#pragma unroll
            for (int r4 = 0; r4 < 4; ++r4) { const f32x4 e0 = *(const f32x4*)(E + 4 * r4), e1 = *(const f32x4*)(E + 16 + 4 * r4);
#pragma unroll
                for (int j = 0; j < 4; ++j) { S0[4 * r4 + j] = S0[4 * r4 + j] * d0 + e0[j]; S1[4 * r4 + j] = S1[4 * r4 + j] * d1 + e1[j]; } } }
    }
    constexpr int nch = L / 64;
    u32x4 pq[2], pg[2], pv[2];
    const unsigned colb = (unsigned)((head * 128 + (tid & 15) * 8) * 2);
    auto chunk_off = [&](int cc, int e) -> unsigned { const int c0 = dir ? (L - 64 * (cc + 1)) : 64 * cc; const int i = (tid >> 4) + 32 * e; const int t = dir ? (c0 + 63 - i) : (c0 + i);
        return (unsigned)(rowbase + t) * (unsigned)(HW * 2) + colb; };
#pragma unroll
    for (int e = 0; e < 2; ++e) { const unsigned o = chunk_off(0, e); pq[e] = passA ? (u32x4){0u, 0u, 0u, 0u} : ldg<u32x4>(hq, o); pg[e] = ldg<u32x4>(gg, o); pv[e] = ldg<u32x4>(hv, o); }
    for (int cc = 0; cc < nch; ++cc) {
        const int c0 = dir ? (L - 64 * (cc + 1)) : 64 * cc;
#pragma unroll
        for (int e = 0; e < 2; ++e) { const unsigned ob = off_b((tid >> 4) + 32 * e, tid & 15); *(LAS u32x4*)(RQ + ob) = pq[e]; *(LAS u32x4*)(RG + ob) = pg[e]; *(LAS u32x4*)(VI + ob) = pv[e]; }
        if (cc + 1 < nch) {
#pragma unroll
            for (int e = 0; e < 2; ++e) { const unsigned o = chunk_off(cc + 1, e); if (!passA) pq[e] = ldg<u32x4>(hq, o); pg[e] = ldg<u32x4>(gg, o); pv[e] = ldg<u32x4>(hv, o); }
        }
        __syncthreads();
        { s16x4 graw[4], qraw[4];
#pragma unroll
          for (int g4 = 0; g4 < 4; ++g4) { const unsigned ad = off_b(32 * tb + 8 * g4 + 4 * h + q4, 4 * kb + 2 * blk + (p >> 1)) + 8 * (p & 1);
              graw[g4] = __builtin_amdgcn_ds_read_tr16_b64_v4i16((LAS s16x4*)(RG + ad)); qraw[g4] = __builtin_amdgcn_ds_read_tr16_b64_v4i16((LAS s16x4*)(RQ + ad)); }
          f32x16 c;
#pragma unroll
          for (int r = 0; r < 16; ++r) c[r] = 0.f;
          float bmid, bend = 0.f;
          if (tb == 0) { c = MFMA32(Ld[0], frag_tr(RG, 0, 32 * kb, lane), c); c = MFMA32(Ld[1], frag_tr(RG, 16, 32 * kb, lane), c); bmid = __shfl(c[15], l31 + 32); }
          else { c = MFMA32(Lone, frag_tr(RG, 0, 32 * kb, lane), c); c = MFMA32(Lone, frag_tr(RG, 16, 32 * kb, lane), c); bmid = c[0];
                 c = MFMA32(Ld[0], frag_tr(RG, 32, 32 * kb, lane), c); c = MFMA32(Ld[1], frag_tr(RG, 48, 32 * kb, lane), c); bend = __shfl(c[15], l31 + 32); }
          const int kk = 32 * kb + l31;
#pragma unroll
          for (int g4 = 0; g4 < 4; ++g4) { float qs[4], ks[4];
#pragma unroll
              for (int j = 0; j < 4; ++j) { const float gv = bf2f((unsigned short)graw[g4][j]), qv = bf2f((unsigned short)qraw[g4][j]); const float x = c[4 * g4 + j] - bmid;
                  qs[j] = qv * fexp2(fminf(x, 100.f)); ks[j] = (1.0f - fexp2(gv)) * fexp2(fminf(-x, 100.f)); }
              const unsigned ad = (unsigned)(kk * T_STR + (32 * tb + 8 * g4 + 4 * h) * 2);
              u32x2 wq, wk; wq.x = pk2(qs[0], qs[1]); wq.y = pk2(qs[2], qs[3]); wk.x = pk2(ks[0], ks[1]); wk.y = pk2(ks[2], ks[3]);
              *(LAS u32x2*)(QT + ad) = wq; *(LAS u32x2*)(KT + ad) = wk; }
          if (tb == 1 && h == 0) { em[kk] = fexp2(bmid); ee[kk] = fexp2(bend); eme[kk] = fexp2(bend - bmid); bel[kk] = bend; } }
        __syncthreads();
        if (!passA) {
#pragma unroll
        for (int e = 0; e < 2; ++e) { const int id = 2 * wave + e, vb2 = id >> 2, kk = e ? kk1 : kk0; const float emk = em[kk];
#pragma unroll
            for (int g4 = 0; g4 < 4; ++g4) { const f32x16& S = e ? S1 : S0; u32x2 w; w.x = pk2(S[4 * g4] * emk, S[4 * g4 + 1] * emk); w.y = pk2(S[4 * g4 + 2] * emk, S[4 * g4 + 3] * emk);
                *(LAS u32x2*)(SI + off_b(kk, 4 * vb2 + g4) + 8 * h) = w; } }
        if (wave < 3) { const int sb = wave == 2 ? 1 : 0, tbm = wave == 0 ? 0 : 1; f32x16 c;
#pragma unroll
            for (int r = 0; r < 16; ++r) c[r] = 0.f;
            { bf16x8 ka = frag_tr144(KT, 0, 32 * sb, lane), qa = frag_tr144(QT, 0, 32 * tbm, lane);
#pragma unroll
              for (int ks = 0; ks < 8; ++ks) { bf16x8 kn = ka, qn = qa;
                  if (ks < 7) { kn = frag_tr144(KT, 16 * (ks + 1), 32 * sb, lane); qn = frag_tr144(QT, 16 * (ks + 1), 32 * tbm, lane); }
                  c = MFMA32(ka, qa, c); ka = kn; qa = qn; } }
            const int t = 32 * tbm + l31;
#pragma unroll
            for (int g4 = 0; g4 < 4; ++g4) { float x[4];
#pragma unroll
                for (int j = 0; j < 4; ++j) { const int sx = 32 * sb + 8 * g4 + 4 * h + j; x[j] = (sx <= t) ? c[4 * g4 + j] : 0.f; }
                u32x2 w; w.x = pk2(x[0], x[1]); w.y = pk2(x[2], x[3]); *(LAS u32x2*)(AI + t * AI_STR + (32 * sb + 8 * g4 + 4 * h) * 2) = w; } }
        }
#pragma unroll
        for (int e = 0; e < 2; ++e) { const int id = 2 * wave + e, vb2 = id >> 2, kk = e ? kk1 : kk0; f32x16 c;
#pragma unroll
            for (int r = 0; r < 16; ++r) c[r] = 0.f;
#pragma unroll
            for (int ks = 0; ks < 4; ++ks) c = MFMA32(frag_tr(VI, 16 * ks, 32 * vb2, lane), *(const LAS bf16x8*)(KT + kk * T_STR + (16 * ks + 8 * h) * 2), c);
            const float eek = ee[kk], emek = eme[kk];
            if (e) { dlog1 += bel[kk];
#pragma unroll
                for (int r = 0; r < 16; ++r) S1[r] = S1[r] * eek + c[r] * emek; }
            else { dlog0 += bel[kk];
#pragma unroll
                for (int r = 0; r < 16; ++r) S0[r] = S0[r] * eek + c[r] * emek; } }
        __syncthreads();
        if (!passA) { const int vb = kb; f32x16 c;
#pragma unroll
          for (int r = 0; r < 16; ++r) c[r] = 0.f;
          const LAS unsigned char* aip = AI + (32 * tb + l31) * AI_STR + 16 * h;
          { bf16x8 xa = frag_tr144(QT, 0, 32 * tb, lane), xb = frag_tr(SI, 0, 32 * vb, lane);
#pragma unroll
            for (int ks = 0; ks < 8; ++ks) { bf16x8 na, nb;
                if (ks < 7) { na = frag_tr144(QT, 16 * (ks + 1), 32 * tb, lane); nb = frag_tr(SI, 16 * (ks + 1), 32 * vb, lane); }
                else { na = *(const LAS bf16x8*)aip; nb = frag_tr(VI, 0, 32 * vb, lane); }
                c = MFMA32(xa, xb, c); xa = na; xb = nb; }
            { bf16x8 na = *(const LAS bf16x8*)(aip + 32), nb = frag_tr(VI, 16, 32 * vb, lane); c = MFMA32(xa, xb, c); xa = na; xb = nb; }
            if (tb) { bf16x8 na = *(const LAS bf16x8*)(aip + 64), nb = frag_tr(VI, 32, 32 * vb, lane); c = MFMA32(xa, xb, c); xa = na; xb = nb;
                      na = *(const LAS bf16x8*)(aip + 96); nb = frag_tr(VI, 48, 32 * vb, lane); c = MFMA32(xa, xb, c); xa = na; xb = nb; }
            c = MFMA32(xa, xb, c); }
          const unsigned lo = (unsigned)((head * 128 + 32 * vb + l31) * 2) + (unsigned)((dir ? 4 - 4 * h : 4 * h) * (HW * 2));
          const int tu0 = __builtin_amdgcn_readfirstlane(rowbase + (dir ? c0 + 63 - 32 * tb - 4 : c0 + 32 * tb));
#pragma unroll
          for (int r = 0; r < 16; r += 2) { const unsigned w = pk2(c[r], c[r + 1]);
              const int d0 = (r & 3) + 8 * (r >> 2), d1 = d0 + 1;
              unsigned char* b0 = oraw + (size_t)(unsigned)(dir ? tu0 - d0 : tu0 + d0) * (size_t)(HW * 2); unsigned char* b1 = oraw + (size_t)(unsigned)(dir ? tu0 - d1 : tu0 + d1) * (size_t)(HW * 2);
              stg<unsigned short>(b0, lo, (unsigned short)(w & 0xffffu)); stg<unsigned short>(b1, lo, (unsigned short)(w >> 16)); }
          __syncthreads(); }
    }
    if (passA) {
        const int slot = (seg * 8 + head) * 2 + dir;
        float* E = (float*)(a.ws + WS_SEGE) + ((size_t)slot * 512 + tid) * 32; float* D = (float*)(a.ws + WS_SEGD) + slot * 128;
#pragma unroll
        for (int r4 = 0; r4 < 4; ++r4) { *(f32x4*)(E + 4 * r4) = (f32x4){S0[4 * r4], S0[4 * r4 + 1], S0[4 * r4 + 2], S0[4 * r4 + 3]}; *(f32x4*)(E + 16 + 4 * r4) = (f32x4){S1[4 * r4], S1[4 * r4 + 1], S1[4 * r4 + 2], S1[4 * r4 + 3]}; }
        if (wave < 2 && h == 0) { D[kk0] = dlog0; D[kk1] = dlog1; }
    }
}

__device__ __forceinline__ void finalize_a(const Args& a, int l, int gw, int ngw, int lane, int m_lo, int m_hi) {
    bf16* of = (bf16*)(a.ws + WS_AOUT); const bf16* ob = (const bf16*)(a.ws + WS_OBWD); const bf16* hg = (const bf16*)(a.ws + P_HG);
    const float* ng = a.hg_norm_g + l * 128;
    const int c8 = (lane & 15) * 8;
    float gv[8];
#pragma unroll
    for (int j = 0; j < 8; ++j) gv[j] = ng[c8 + j];
    const unsigned lo = (unsigned)(((lane >> 4) * 128 + c8) * 2);
    struct Rows { u32x4 f[2], b[2], g[2]; };
    auto load = [&](Rows& R, int m) {
#pragma unroll
        for (int p = 0; p < 2; ++p) { const unsigned o = (unsigned)m * (unsigned)(HW * 2) + lo + (unsigned)(p * 1024); R.f[p] = ldg<u32x4>(of, o); R.b[p] = ldg<u32x4>(ob, o); R.g[p] = ldg<u32x4>(hg, o); } };
    auto finish = [&](const Rows& R, int m) {
#pragma unroll
        for (int p = 0; p < 2; ++p) {
            float x[8], ss = 0.f;
#pragma unroll
            for (int j = 0; j < 8; ++j) { const unsigned fw = R.f[p][j >> 1], bw = R.b[p][j >> 1]; const float fv = (j & 1) ? __uint_as_float(fw & 0xffff0000u) : __uint_as_float(fw << 16);
                const float bv = (j & 1) ? __uint_as_float(bw & 0xffff0000u) : __uint_as_float(bw << 16); x[j] = fv + bv; ss += x[j] * x[j]; }
            ss += __shfl_xor(ss, 1); ss += __shfl_xor(ss, 2); ss += __shfl_xor(ss, 4); ss += __shfl_xor(ss, 8);
            const float rs = 1.0f / sqrtf(ss * (1.0f / 128.0f) + RMS_EPS);
            float r[8];
#pragma unroll
            for (int j = 0; j < 8; ++j) { const unsigned gw_ = R.g[p][j >> 1]; const float gt = (j & 1) ? __uint_as_float(gw_ & 0xffff0000u) : __uint_as_float(gw_ << 16); r[j] = x[j] * rs * gv[j] * gt; }
            u32x4 w; w.x = pk2(r[0], r[1]); w.y = pk2(r[2], r[3]); w.z = pk2(r[4], r[5]); w.w = pk2(r[6], r[7]);
            stg<u32x4>(of, (unsigned)m * (unsigned)(HW * 2) + lo + (unsigned)(p * 1024), w); } };
    Rows A, B;
    int m = m_lo + gw;
    if (m < m_hi) load(A, m);
    for (; m < m_hi; m += 2 * ngw) {
        const bool hb = m + ngw < m_hi;
        if (hb) load(B, m + ngw);
        asm volatile("" ::: "memory");
        finish(A, m);
        if (!hb) break;
        if (m + 2 * ngw < m_hi) load(A, m + 2 * ngw);
        asm volatile("" ::: "memory");
        finish(B, m + ngw);
    }
}

constexpr int AT_K = 0, AT_V = 32768, AT_BUF = 65536;
static_assert(2 * AT_BUF <= RING_BYTES, "attention LDS");
__device__ __forceinline__ void attn_unit(const Args& a, int l, LAS unsigned char* lds, int unit, int tid, int wave, int lane) {
    const int nb = unit >> 2, hk = (unit >> 1) & 1, hh = unit & 1;
    int n, N; if (nb < 256) { n = nb & 15; N = 16; } else { n = nb - 256; N = 64; }
    const int qhead = 4 * hk + 2 * hh + (wave >> 2), qt = wave & 3, h = lane >> 5, l31 = lane & 31;
    const bf16* aq = (const bf16*)(a.ws + P_AQ); const unsigned char* ak = a.ws + P_AK; const unsigned char* av = a.ws + P_AV; unsigned char* bo = a.ws + WS_BOUT;
    const int qi = 32 * qt + l31;
    const size_t qrow = (size_t)nb * 128 + qi;
    const int kb_lo = n > 0 ? n - 1 : 0, kb_hi = n + 1 < N ? n + 1 : N - 1;
    auto stage = [&](int kb, int b) {
        const unsigned rowoff = (unsigned)((nb + (kb - n)) * 128) * (unsigned)(KVW * 2) + (unsigned)(hk * 256);
#pragma unroll
        for (int e = 0; e < 4; ++e) { const unsigned row = (unsigned)(e * 32 + (tid >> 4)), ch = (unsigned)(tid & 15) ^ (((row & 3) << 2) | ((row >> 2) & 3));
            const unsigned go = rowoff + row * (unsigned)(KVW * 2) + ch * 16u;
            __builtin_amdgcn_global_load_lds((const GAS unsigned*)((const GAS unsigned char*)ak + go), (LAS unsigned*)(lds + b * AT_BUF + AT_K + e * 8192 + wave * 1024), 16, 0, 0);
            __builtin_amdgcn_global_load_lds((const GAS unsigned*)((const GAS unsigned char*)av + go), (LAS unsigned*)(lds + b * AT_BUF + AT_V + e * 8192 + wave * 1024), 16, 0, 0); } };
    __syncthreads();
    stage(kb_lo, 0);
    bf16x8 qf[8];
#pragma unroll
    for (int ks = 0; ks < 8; ++ks) qf[ks] = *(const bf16x8*)(aq + qrow * HW + qhead * 128 + 16 * ks + 8 * h);
    f32x16 O[4];
#pragma unroll
    for (int c = 0; c < 4; ++c)
#pragma unroll
        for (int r = 0; r < 16; ++r) O[c][r] = 0.f;
    float mrun = a.attn_sink[l * 8 + qhead] * LOG2E, lrun = 1.0f;
    int b = 0;
    for (int kb = kb_lo; kb <= kb_hi; ++kb, b ^= 1) {
        asm volatile("s_waitcnt vmcnt(0)" ::: "memory");
        __syncthreads();
        if (kb < kb_hi) stage(kb + 1, b ^ 1);
        const LAS unsigned char* KI = lds + b * AT_BUF + AT_K; const LAS unsigned char* VI = lds + b * AT_BUF + AT_V;
        const int rel = kb - n;
        for (int kt = 0; kt < 4; ++kt) {
            if ((rel < 0 && kt < qt) || (rel > 0 && kt > qt)) continue;
            f32x16 s;
#pragma unroll
            for (int r = 0; r < 16; ++r) s[r] = 0.f;
#pragma unroll
            for (int ks = 0; ks < 8; ++ks) s = MFMA32(frag_row(KI, 32 * kt, ks, lane), qf[ks], s);
            if (rel != 0 && kt == qt) {
#pragma unroll
                for (int r = 0; r < 16; ++r) { const int jj = 32 * kt + crow(r, h); const bool ok = rel < 0 ? (jj >= qi) : (jj <= qi); s[r] = ok ? s[r] : -__builtin_inff(); } }
            float mx = s[0];
#pragma unroll
            for (int r = 1; r < 16; ++r) mx = fmaxf(mx, s[r]);
            mx = fmaxf(mx, __shfl_xor(mx, 32));
            const float mnew = fmaxf(mrun, mx), alpha = fexp2(mrun - mnew); mrun = mnew;
            float ps = 0.f;
#pragma unroll
            for (int r = 0; r < 16; ++r) { s[r] = fexp2(s[r] - mnew); ps += s[r]; }
            ps += __shfl_xor(ps, 32);
            lrun = lrun * alpha + ps;
            bf16x8 pf[2];
#pragma unroll
            for (int sx = 0; sx < 2; ++sx) { u32x4 w; w.x = pk2(s[8 * sx], s[8 * sx + 1]); w.y = pk2(s[8 * sx + 2], s[8 * sx + 3]); w.z = pk2(s[8 * sx + 4], s[8 * sx + 5]); w.w = pk2(s[8 * sx + 6], s[8 * sx + 7]);
                pf[sx] = __builtin_bit_cast(bf16x8, w); }
            if (__builtin_amdgcn_ballot_w64(alpha != 1.0f) != 0ull) {
#pragma unroll
                for (int c = 0; c < 4; ++c)
#pragma unroll
                    for (int r = 0; r < 16; ++r) O[c][r] *= alpha; }
#pragma unroll
            for (int c = 0; c < 4; ++c)
#pragma unroll
                for (int sx = 0; sx < 2; ++sx) O[c] = MFMA32(frag_tr_acc(VI, 32 * kt + 16 * sx, 32 * c, lane), pf[sx], O[c]);
        }
    }
    const float inv = 1.0f / lrun;
    const unsigned oo = (unsigned)(((unsigned)qrow * HW + qhead * 128 + 4 * h) * 2);
#pragma unroll
    for (int c = 0; c < 4; ++c)
#pragma unroll
        for (int g4 = 0; g4 < 4; ++g4) { u32x2 w; w.x = pk2(O[c][4 * g4] * inv, O[c][4 * g4 + 1] * inv); w.y = pk2(O[c][4 * g4 + 2] * inv, O[c][4 * g4 + 3] * inv);
            stg<u32x2>(bo, oo + (unsigned)((32 * c + 8 * g4) * 2), w); }
}


__device__ __forceinline__ void final_ln(const Args& a, int gw, int ngw, int lane) {
    const float* st = (const float*)(a.ws + WS_STATS + 8 * STATS_BYTES); const float* g = a.ln2_g + 3 * DM; const float* b = a.ln2_b + 3 * DM;
    for (int m = gw; m < MTOK; m += ngw) { float A, B; row_norm(st, m, A, B);
        f32x4* yr = (f32x4*)(a.out + (size_t)m * DM) + lane;
#pragma unroll
        for (int j = 0; j < 8; ++j) { const f32x4 v = yr[64 * j], gv = *((const f32x4*)g + lane + 64 * j), bv = *((const f32x4*)b + lane + 64 * j); yr[64 * j] = (v * A + B) * gv + bv; } }
}

constexpr int N_PHASES = 1 + 8 * DEPTH + 1;
constexpr int FIN_EARLY = 10 * SEQ_P;
#ifndef PH_MASK
#define PH_MASK 0xfff
#endif
#define PHON(j) (((PH_MASK) >> (j)) & 1)
__global__ void __launch_bounds__(NTHREADS, 2) enc_fwd(Args a0) {
    extern __shared__ __attribute__((aligned(16))) unsigned char lds_raw[];
    LAS unsigned char* lds = (LAS unsigned char*)lds_raw;
    volatile LAS unsigned* MISC = (volatile LAS unsigned*)(lds + MISC_OFF);
    const int tid0 = threadIdx.x, wave = __builtin_amdgcn_readfirstlane(tid0 >> 6);
    const int G = gridDim.x, bx = blockIdx.x;
    const int vcu = (G % 8 == 0) ? (bx % 8) * (G / 8) + bx / 8 : bx;
    const int gw = vcu * NWAVES + wave, ngw = G * NWAVES;
    for (int u = tid0; u < (LDS_BYTES - MISC_OFF) / 4; u += NTHREADS) ((LAS unsigned*)(lds + MISC_OFF))[u] = 0u;
    __syncthreads();
    XcdBarrier bar; bar.bar = (unsigned*)(a0.ws + WS_CTL); bar.x = 0; bar.st = nullptr;
#if !MK_PER_PHASE_LAUNCH
    bar = xcd_barrier_post((unsigned*)(a0.ws + WS_CTL), MISC + 8, tid0 == 0);
#endif
    const int lo = a0.ph_lo, hi = a0.ph_hi;
#define IN(k) (lo <= (k) && (k) < hi)
#define LAUNDER() int tid = wave * 64 + lane_id(); asm volatile("" : "+v"(tid)); const int lane = tid & 63; Args a = a0; asm volatile("" : "+s"(a.ws), "+s"(a.out))
#if MK_PER_PHASE_LAUNCH
#define SEAM(k) do { } while (0)
#else
#define SEAM(k) do { if ((k) + 1 < hi) xcd_barrier(bar, wave == 0 && lane_id() == 0); } while (0)
#endif
    if (PHON(8) && IN(0)) { LAUNDER(); prologue(a, gw, ngw, lane); SEAM(0); }

#ifndef PROBE_MIX
#define PROBE_MIX 0
#endif
#if PROBE_MIX
    for (int it_ = 0; it_ < 2 * DEPTH; ++it_) {
        int it = it_; asm volatile("" : "+s"(it)); int l = it >> 1; const int sub = it & 1;
#else
    for (int l_ = 0; l_ < DEPTH; ++l_) {
        int l = l_; asm volatile("" : "+s"(l));
        constexpr int sub = -1;
#endif
        const bool do_scan = sub != 1 || PROBE_MIX != 3, do_attn = sub != 1 || PROBE_MIX != 2, do_fin = sub != 1 || PROBE_MIX != 3;
        const int pb = 1 + 8 * l;
#define LOCALS() LAUNDER(); unsigned char* wsw = a.ws + WS_W; float* cv = (float*)(a.ws + WS_CVEC + (size_t)l * CVEC_LAYER); \
        const float* stats_in = (const float*)(a.ws + WS_STATS + (size_t)(l == 0 ? 0 : 2 * l) * STATS_BYTES); \
        float* stats_1 = (float*)(a.ws + WS_STATS + (size_t)(1 + 2 * l) * STATS_BYTES); float* stats_2 = (float*)(a.ws + WS_STATS + (size_t)(2 + 2 * l) * STATS_BYTES); \
        bf16* ybf = (bf16*)(a.ws + WS_YBF); (void)wsw; (void)cv; (void)stats_in; (void)stats_1; (void)stats_2; (void)ybf
        if (sub != 1 && PHON(0) && IN(pb + 0)) { LOCALS(); convert_layer(a, l, lds, gw, ngw, wave, lane); SEAM(pb + 0); }
        if (sub != 1 && PHON(1) && IN(pb + 1)) { LOCALS();
            pg8::Gemm g{ybf, nullptr, (const bf16*)(wsw + W_IN), MTOK, NPROJ, DM, DM}; pg8::StaticOrder S; S.init(MTOK, NPROJ, G, bx);
            EpiProj E{a.ws, stats_in, cv, cv + NPROJ, (const float*)(a.ws + WS_LB) + l * 2048};
            pg8::gemm_phase<EpiProj, pg8::StaticOrder>(lds, g, S, E, wave);
            SEAM(pb + 1);
        }
        if (PHON(2) && IN(pb + 2)) { LOCALS();
            if (do_scan) for (int u = bx; u < 256; u += G) {
                if (u < 48) { const int hd = u & 7, dir = (u >> 3) & 1, seg = (u >> 4) + dir; scan_unit<1>(a, lds, NSEQ_P * SEQ_P + seg * SEQ_P, hd, dir, seg, tid, wave, lane); }
                else { const int v = u - 48; scan_unit<0>(a, lds, (v >> 4) * SEQ_P, (v >> 1) & 7, v & 1, 0, tid, wave, lane); }
            }
            if (do_attn && G == 256) { const int an0 = bx < 48 ? 3 : 1, a00 = bx < 48 ? 3 * bx : 144 + (bx - 48); for (int j = 0; j < an0; ++j) attn_unit(a, l, lds, a00 + j, tid, wave, lane); }
            __syncthreads();
            xcd_barrier(bar, wave == 0 && lane_id() == 0);
            if (do_scan) for (int u = bx; u < 112; u += G) {
                if (u < 48) { const int v = 208 + u; scan_unit<0>(a, lds, (v >> 4) * SEQ_P, (v >> 1) & 7, v & 1, 0, tid, wave, lane); }
                else { const int v = u - 48, seg = v >> 4; scan_unit<2>(a, lds, NSEQ_P * SEQ_P + seg * SEQ_P, (v >> 1) & 7, v & 1, seg, tid, wave, lane); }
            }
            { int a0 = bx, astr = G, an = (1280 - bx + G - 1) / G, aex = -1;
              if (G == 256) { astr = 1; if (bx < 112) { a0 = 352 + 2 * bx; an = 2; } else { const int w = bx - 112; a0 = 576 + (w < 128 ? 5 * w : 640 + 4 * (w - 128)); an = w < 128 ? 5 : 4; } }
              if (do_attn) for (int j = 0; j < an + (aex >= 0 ? 1 : 0); ++j) attn_unit(a, l, lds, j < an ? a0 + j * astr : aex, tid, wave, lane);
              if (do_fin && G == 256 && bx >= 112) finalize_a(a, l, (bx - 112) * NWAVES + wave, 144 * NWAVES, lane, 0, FIN_EARLY); }
            __syncthreads();
            SEAM(pb + 2);
        }
        if (sub != 0 && PHON(3) && IN(pb + 3)) { LOCALS(); finalize_a(a, l, gw, ngw, lane, G == 256 ? FIN_EARLY : 0, MTOK); SEAM(pb + 3); }
        if (sub != 0 && PHON(4) && IN(pb + 4)) { LOCALS();
            pg8::Gemm g{(const bf16*)(a.ws + WS_AOUT), (const bf16*)(a.ws + WS_BOUT), (const bf16*)(wsw + W_A), MTOK, DM, DM, HW}; pg8::StaticOrder S; S.init(MTOK, DM, G, bx);
            EpiMergeF E{(const bf16*)(a.ws + P_GA), (const bf16*)(a.ws + P_GBB), (bf16*)(a.ws + WS_MERGED)};
            pg8::gemm_phase<EpiMergeF, pg8::StaticOrder>(lds, g, S, E, wave);
            SEAM(pb + 4);
        }
        if (sub != 0 && PHON(5) && IN(pb + 5)) { LOCALS();
            pg8::Gemm g{(const bf16*)(a.ws + WS_MERGED), nullptr, (const bf16*)(wsw + W_OUT), MTOK, DM, DM, DM}; pg8::StaticOrder S; S.init(MTOK, DM, G, bx);
            const float* gi = l == 0 ? a.ln_in_g : a.ln2_g + (size_t)(l - 1) * DM; const float* bi = l == 0 ? a.ln_in_b : a.ln2_b + (size_t)(l - 1) * DM;
            if (l == 0) { EpiResid<0> E{a.xp, a.xs, nullptr, stats_in, gi, bi, (unsigned short*)(a.ws + P_GA), (bf16*)(a.ws + P_GBB), nullptr, stats_1};
                pg8::gemm_phase<EpiResid<0>, pg8::StaticOrder>(lds, g, S, E, wave); }
            else { EpiResid<1> E{nullptr, nullptr, (const unsigned short*)a.out, stats_in, gi, bi, (unsigned short*)(a.ws + P_GA), (bf16*)(a.ws + P_GBB), nullptr, stats_1};
                pg8::gemm_phase<EpiResid<1>, pg8::StaticOrder>(lds, g, S, E, wave); }
            SEAM(pb + 5);
        }
        if (sub != 0 && PHON(6) && IN(pb + 6)) { LOCALS();
            pg8::Gemm g{(const bf16*)(a.ws + P_GBB), nullptr, (const bf16*)(wsw + W_FIN), MTOK, NFFN, DM, DM}; pg8::StaticOrder S; S.init(MTOK, NFFN, G, bx);
            EpiSwiglu E{stats_1, cv + 2 * NPROJ, cv + 2 * NPROJ + NFFN, (bf16*)(a.ws + WS_HID)};
            pg8::gemm_phase<EpiSwiglu, pg8::StaticOrder>(lds, g, S, E, wave);
            SEAM(pb + 6);
        }
        if (sub != 0 && PHON(7) && IN(pb + 7)) { LOCALS();
            pg8::Gemm g{(const bf16*)(a.ws + WS_HID), nullptr, (const bf16*)(wsw + W_FOUT), MTOK, DM, DFF, DFF}; pg8::StaticOrder S; S.init(MTOK, DM, G, bx);
            EpiResid<1> E{nullptr, nullptr, (const unsigned short*)(a.ws + P_GA), stats_1, a.ln1_g + (size_t)l * DM, a.ln1_b + (size_t)l * DM,
                          l == DEPTH - 1 ? nullptr : (unsigned short*)a.out, l == DEPTH - 1 ? nullptr : ybf, l == DEPTH - 1 ? a.out : nullptr, stats_2};
            pg8::gemm_phase<EpiResid<1>, pg8::StaticOrder>(lds, g, S, E, wave);
            SEAM(pb + 7);
        }
    }
    if (PHON(9) && IN(N_PHASES - 1)) { LAUNDER(); final_ln(a, gw, ngw, lane); }
#undef IN
#undef SEAM
#undef LAUNDER
#undef LOCALS
}

extern "C" void kernel_launch(void* const* d_in, const int* in_sizes, int n_in, void* d_out, int out_size, void* d_ws, size_t ws_size, hipStream_t stream) {
    static int grid = 0;
    if (grid == 0) {
        if (n_in != 17 || out_size != MTOK * DM || ws_size < WS_END) { fprintf(stderr, "kernel_launch: unexpected shapes (n_in %d out %d ws %zu need %zu)\n", n_in, out_size, ws_size, (size_t)WS_END); grid = -1; return; }
        int dev = 0, cus = 0, per_cu = 0;
        if (hipGetDevice(&dev) != hipSuccess || hipDeviceGetAttribute(&cus, hipDeviceAttributeMultiprocessorCount, dev) != hipSuccess) { grid = -1; return; }
        if (hipFuncSetAttribute((const void*)enc_fwd, hipFuncAttributeMaxDynamicSharedMemorySize, LDS_BYTES) != hipSuccess) { fprintf(stderr, "kernel_launch: hipFuncSetAttribute failed\n"); grid = -1; return; }
        if (hipOccupancyMaxActiveBlocksPerMultiprocessor(&per_cu, (const void*)enc_fwd, NTHREADS, LDS_BYTES) != hipSuccess || per_cu < 1) { fprintf(stderr, "kernel_launch: occupancy query says %d\n", per_cu); }
        (void)hipGetLastError();
        grid = cus;
    }
    if (grid < 0) return;
    (void)hipMemsetAsync((char*)d_ws, 0, ZERO_BYTES, stream);
    Args a{};
    a.xp = (const float*)d_in[0]; a.xs = (const float*)d_in[1]; a.ln_in_g = (const float*)d_in[2]; a.ln_in_b = (const float*)d_in[3]; a.w_in = (const float*)d_in[4];
    a.lb_logits = (const float*)d_in[5]; a.hg_norm_g = (const float*)d_in[6]; a.attn_sink = (const float*)d_in[7]; a.w_a = (const float*)d_in[8]; a.w_b = (const float*)d_in[9];
    a.w_out = (const float*)d_in[10]; a.ln1_g = (const float*)d_in[11]; a.ln1_b = (const float*)d_in[12]; a.w_ffn_in = (const float*)d_in[13]; a.w_ffn_out = (const float*)d_in[14];
    a.ln2_g = (const float*)d_in[15]; a.ln2_b = (const float*)d_in[16]; a.out = (float*)d_out; a.ws = (unsigned char*)d_ws;
#if MK_PER_PHASE_LAUNCH
    for (int p = 0; p < N_PHASES; ++p) { a.ph_lo = p; a.ph_hi = p + 1; hipLaunchKernelGGL(enc_fwd, dim3(grid), dim3(NTHREADS), LDS_BYTES, stream, a); }
#else
    a.ph_lo = 0; a.ph_hi = N_PHASES;
    hipLaunchKernelGGL(enc_fwd, dim3(grid), dim3(NTHREADS), LDS_BYTES, stream, a);
#endif
}
```
